# Optimizing an MI355X kernel written in HIP

```python
import math
import jax, jax.numpy as jnp
from jax import lax
import numpy as np

D_MODEL = 1024
BATCH = 4
SEQ = 8192
DEPTH = 2

D_MIX = D_MODEL
GLA_HEADS = 4
GLA_DV = D_MIX // 2 // GLA_HEADS
GLA_DK = GLA_DV // 2
GLA_LOWRANK = 16
GLA_TAU = 16.0
GLA_CHUNK = 64
SWA_HEADS = 8
SWA_KV_HEADS = 2
SWA_HD = (D_MIX - GLA_HEADS * GLA_DV) // SWA_HEADS
SWA_WINDOW = 128
D_FF = 2816
CONV_K = 3
EPS = 1e-6

GLA_Q = GLA_HEADS * GLA_DK
GLA_K = GLA_HEADS * GLA_DK
GLA_V = GLA_HEADS * GLA_DV
GLA_R = GLA_HEADS * GLA_DV
SWA_Q = SWA_HEADS * SWA_HD
SWA_K = SWA_KV_HEADS * SWA_HD
SWA_V = SWA_KV_HEADS * SWA_HD
SPLITS = (GLA_Q, GLA_K, GLA_V, GLA_R, GLA_LOWRANK, SWA_Q, SWA_K, SWA_V)
P_IN = sum(SPLITS)

kernel_name = "hymba_gla_swa_sink_convffn"


def alibi_slopes(n_heads):
    return np.array([2.0 ** (-8.0 * (h + 1) / n_heads) for h in range(n_heads)], dtype=np.float32)


def rms_norm(x, g):
    xf = x.astype(jnp.float32)
    y = xf * lax.rsqrt(jnp.mean(xf * xf, axis=-1, keepdims=True) + EPS)
    return (y * g.astype(jnp.float32)).astype(x.dtype)


def split_cols(z, sizes):
    idx = np.cumsum(sizes)[:-1].tolist()
    return jnp.split(z, idx, axis=-1)


def gla_chunked(q, k, v, log_a):
    B, L, H, dk = q.shape
    dv = v.shape[-1]
    C = GLA_CHUNK
    n = L // C

    def chunk(t):
        return t.astype(jnp.float32).reshape(B, n, C, H, t.shape[-1]).transpose(0, 3, 1, 2, 4)

    q, k, v, log_a = chunk(q), chunk(k), chunk(v), chunk(log_a)
    b = jnp.cumsum(log_a, axis=-2)
    b_last = b[..., -1:, :]
    qe = q * jnp.exp(b)
    ke = k * jnp.exp(-b)
    causal = jnp.tril(jnp.ones((C, C), dtype=bool))
    A = jnp.einsum('bhncd,bhnsd->bhncs', qe, ke)
    A = jnp.where(causal, A, 0.0)
    o_intra = jnp.einsum('bhncs,bhnsv->bhncv', A, v)
    kd = k * jnp.exp(b_last - b)
    chunk_state = jnp.einsum('bhncd,bhncv->bhndv', kd, v)
    decay = jnp.exp(b_last[..., 0, :])

    def step(S, inp):
        dec, cs = inp
        return S * dec[..., None] + cs, S

    S0 = jnp.zeros((B, H, dk, dv), jnp.float32)
    _, S_prev = lax.scan(step, S0, (jnp.moveaxis(decay, 2, 0), jnp.moveaxis(chunk_state, 2, 0)))
    S_prev = jnp.moveaxis(S_prev, 0, 2)
    o_inter = jnp.einsum('bhncd,bhndv->bhncv', qe, S_prev)
    o = o_intra + o_inter
    return o.transpose(0, 2, 3, 1, 4).reshape(B, L, H, dv)


def swa_sink_attention(q, k, v, sinks):
    B, L, Hq, hd = q.shape
    Hkv = k.shape[2]
    G = Hq // Hkv
    W = SWA_WINDOW
    nb = L // W
    qb = q.reshape(B, nb, W, Hkv, G, hd)
    kb = k.reshape(B, nb, W, Hkv, hd)
    vb = v.reshape(B, nb, W, Hkv, hd)
    pad = ((0, 0), (1, 0), (0, 0), (0, 0), (0, 0))
    kk = jnp.concatenate([jnp.pad(kb, pad)[:, :-1], kb], axis=2)
    vv = jnp.concatenate([jnp.pad(vb, pad)[:, :-1], vb], axis=2)
    s = jnp.einsum('bnqkgd,bnskd->bnkgqs', qb, kk,
                   preferred_element_type=jnp.float32) * (1.0 / math.sqrt(hd))
    i = jnp.arange(W)[:, None]
    j = jnp.arange(2 * W)[None, :]
    dist = (W + i - j).astype(jnp.float32)
    key_abs = (jnp.arange(nb)[:, None, None] - 1) * W + j[None]
    mask = (dist >= 0) & (dist < W) & (key_abs >= 0)
    slopes = jnp.asarray(alibi_slopes(Hq)).reshape(Hkv, G)
    s = s - slopes[:, :, None, None] * dist
    s = jnp.where(mask[None, :, None, None], s, -jnp.inf)
    sink = sinks.astype(jnp.float32).reshape(Hkv, G)[None, None, :, :, None, None]
    m = jnp.maximum(jnp.max(s, axis=-1, keepdims=True), sink)
    p = jnp.exp(s - m)
    denom = jnp.sum(p, axis=-1, keepdims=True) + jnp.exp(sink - m)
    p = p / denom
    o = jnp.einsum('bnkgqs,bnskd->bnqkgd', p, vv.astype(jnp.float32))
    return o.reshape(B, L, Hq * hd)


def causal_dwconv(u, w, b):
    K = w.shape[0]
    L = u.shape[1]
    up = jnp.pad(u, ((0, 0), (K - 1, 0), (0, 0)))
    out = up[:, 0:L] * w[0]
    for j in range(1, K):
        out = out + up[:, j:j + L] * w[j]
    return out + b


def hybrid_layer(x, mix_norm, w_in, w_alpha2, b_alpha, gla_norm, q_norm, k_norm, sinks,
                 w_out, ffn_norm, w_up, conv_w, conv_b, w_down):
    B, L, _ = x.shape
    dt = x.dtype
    h = rms_norm(x, mix_norm)
    z = h @ w_in
    gq, gk, gv, gr, glr, sq, sk, sv = split_cols(z, SPLITS)

    log_a = jax.nn.log_sigmoid((glr @ w_alpha2 + b_alpha).astype(jnp.float32)) / GLA_TAU
    gq = gq.reshape(B, L, GLA_HEADS, GLA_DK) * (GLA_DK ** -0.5)
    gk = gk.reshape(B, L, GLA_HEADS, GLA_DK)
    gv = gv.reshape(B, L, GLA_HEADS, GLA_DV)
    o_gla = gla_chunked(gq, gk, gv, log_a.reshape(B, L, GLA_HEADS, GLA_DK))
    o_gla = rms_norm(o_gla, gla_norm).reshape(B, L, GLA_V)
    o_gla = (o_gla * jax.nn.silu(gr.astype(jnp.float32))).astype(dt)

    sq = rms_norm(sq.reshape(B, L, SWA_HEADS, SWA_HD), q_norm)
    sk = rms_norm(sk.reshape(B, L, SWA_KV_HEADS, SWA_HD), k_norm)
    sv = sv.reshape(B, L, SWA_KV_HEADS, SWA_HD)
    o_swa = swa_sink_attention(sq, sk, sv, sinks).astype(dt)

    x = x + jnp.concatenate([o_gla, o_swa], axis=-1) @ w_out

    h2 = rms_norm(x, ffn_norm)
    u = causal_dwconv(h2 @ w_up, conv_w, conv_b)
    a, bval = jnp.split(u, 2, axis=-1)
    return x + (jax.nn.silu(a) * bval) @ w_down


def setup_inputs(seed: int = 0) -> dict:
    key = jax.random.key(seed)
    ks = jax.random.split(key, 16)
    f = jnp.float32

    def nrm(k, shape, scale):
        return jax.random.normal(k, shape, f) * scale

    return {
        "x": nrm(ks[0], (BATCH, SEQ, D_MODEL), 1.0),
        "mix_norm": 1.0 + nrm(ks[1], (DEPTH, D_MODEL), 0.02),
        "w_in": nrm(ks[2], (DEPTH, D_MODEL, P_IN), D_MODEL ** -0.5),
        "w_alpha2": nrm(ks[3], (DEPTH, GLA_LOWRANK, GLA_Q), GLA_LOWRANK ** -0.5),
        "b_alpha": nrm(ks[4], (DEPTH, GLA_Q), 0.1),
        "gla_norm": 1.0 + nrm(ks[5], (DEPTH, GLA_DV), 0.02),
        "q_norm": 1.0 + nrm(ks[6], (DEPTH, SWA_HD), 0.02),
        "k_norm": 1.0 + nrm(ks[7], (DEPTH, SWA_HD), 0.02),
        "sinks": nrm(ks[8], (DEPTH, SWA_HEADS), 0.5),
        "w_out": nrm(ks[9], (DEPTH, D_MIX, D_MODEL), (2.0 * D_MIX) ** -0.5),
        "ffn_norm": 1.0 + nrm(ks[10], (DEPTH, D_MODEL), 0.02),
        "w_up": nrm(ks[11], (DEPTH, D_MODEL, 2 * D_FF), D_MODEL ** -0.5),
        "conv_w": nrm(ks[12], (DEPTH, CONV_K, 2 * D_FF), CONV_K ** -0.5),
        "conv_b": nrm(ks[13], (DEPTH, 2 * D_FF), 0.02),
        "w_down": nrm(ks[14], (DEPTH, D_FF, D_MODEL), (2.0 * D_FF) ** -0.5),
    }


def reference(x, mix_norm, w_in, w_alpha2, b_alpha, gla_norm, q_norm, k_norm, sinks,
              w_out, ffn_norm, w_up, conv_w, conv_b, w_down):
    for l in range(DEPTH):
        x = hybrid_layer(x, mix_norm[l], w_in[l], w_alpha2[l], b_alpha[l], gla_norm[l],
                         q_norm[l], k_norm[l], sinks[l], w_out[l], ffn_norm[l], w_up[l],
                         conv_w[l], conv_b[l], w_down[l])
    return x
```

```cpp
#include <hip/hip_runtime.h>
#include <hip/hip_cooperative_groups.h>
#include <cstdio>
#include <cstdint>
namespace cg = cooperative_groups;
namespace pg8 {
#define PG8_LAS __attribute__((address_space(3)))
typedef unsigned short bf16_t;
typedef short bf16x8 __attribute__((ext_vector_type(8)));
typedef float f32x4 __attribute__((ext_vector_type(4)));
typedef unsigned u32x4 __attribute__((ext_vector_type(4)));
constexpr int BM = 256, BK = 64, HALF = 128, HTB = HALF * BK * 2  , STAGE_BYTES = 8 * HTB, NXCD = 8, WGM = 8;

__host__ __device__ __forceinline__ int lds_byte(int r, int c) { const int st = (r >> 4) * 2 + (c >> 5), rr = r & 15, cc = c & 31, ob = rr * 64 + cc * 2; return st * 1024 + (ob ^ (((ob >> 9) & 1) << 5)); }
__host__ __device__ __forceinline__ void stage_rc(int b, int& R, int& C) { const int st = b / 1024, sb = b % 1024, swz = sb ^ (((sb >> 9) & 1) << 5); R = (st >> 1) * 16 + swz / 64; C = (st & 1) * 32 + (swz % 64) / 2; }
__host__ __device__ __forceinline__ int perm32(int rho) { const int n = rho >> 4, i = rho & 15; return 8 * (i >> 2) + 4 * n + (i & 3); }

struct Unit { int pm, pn, ui; };
struct Gemm { const bf16_t* A; const bf16_t* Bt; int M, N, K; };

struct StaticOrder {
    int nM, nN, nwg, G, c;
    __host__ __device__ void init(int M, int N, int G_, int c_) { nM = M / BM; nN = N / BM; nwg = nM * nN; G = G_; c = c_; }
    __host__ __device__ bool next(int i, Unit& u) const {
        const long L = (long)i * G + c; if (L >= nwg) return false;
        int wgid = (int)L; { const int q = nwg / NXCD, r = nwg % NXCD, xcd = wgid % NXCD, off = wgid / NXCD; wgid = (xcd < r ? xcd * (q + 1) : r * (q + 1) + (xcd - r) * q) + off; }
        const int nig = WGM * nN, gid = wgid / nig, fm = gid * WGM, gsz = (nM - fm) < WGM ? (nM - fm) : WGM;
        u.pm = fm + ((wgid % nig) % gsz); u.pn = (wgid % nig) / gsz; u.ui = i; return true;
    }
    __device__ __forceinline__ void a_ready(const Unit&) const {}
    __device__ __forceinline__ void done(const Unit&) const {}
};
struct PairOrder {
    StaticOrder so; bool pair; int pm, pn0;
    __host__ __device__ void init(int M, int N, int G_, int c_) { so.init(M, N, G_, c_); pair = (G_ == 256 && so.nM == 128 && so.nN == 4);
        const int xcd = c_ & 7, j = c_ >> 3; pm = xcd * 16 + (j & 15); pn0 = (j >> 4) * 2; }
    __host__ __device__ bool next(int i, Unit& u) const { if (!pair) return so.next(i, u); if (i >= 2) return false; u.pm = pm; u.pn = pn0 + i; u.ui = i; return true; }
    __device__ __forceinline__ void a_ready(const Unit&) const {}
    __device__ __forceinline__ void done(const Unit&) const {}
};


__device__ __forceinline__ unsigned cvt_pk_bf16(float lo, float hi) { unsigned r; asm volatile("v_cvt_pk_bf16_f32 %0, %1, %2" : "=v"(r) : "v"(lo), "v"(hi)); return r; }
typedef float f32x2 __attribute__((ext_vector_type(2)));
constexpr float RMS_EPS = 1e-6f;
constexpr int ZLD = 2304, FF2 = 5632, FF = 2816, DM = 1024;
__device__ __forceinline__ float row_rstd16(const float* ssq, int row) {
    const f32x4* p = (const f32x4*)(ssq + (size_t)row * 16);
    const f32x4 a = p[0], b = p[1], c = p[2], d = p[3];
    const float s = (((a[0] + a[1]) + (a[2] + a[3])) + ((b[0] + b[1]) + (b[2] + b[3]))) + (((c[0] + c[1]) + (c[2] + c[3])) + ((d[0] + d[1]) + (d[2] + d[3])));
    return rsqrtf(s * (1.0f / 1024.0f) + RMS_EPS);
}
__device__ __forceinline__ void rstd_to_lds(const float* ssq, int row_base, PG8_LAS float* R, int wr, int wc, int fr, int fq) {
    const int tid = (wr * 4 + wc) * 64 + fq * 16 + fr;
    if (tid < 256) R[tid] = row_rstd16(ssq, row_base + tid);
    asm volatile("s_waitcnt lgkmcnt(0)" ::: "memory"); __builtin_amdgcn_s_barrier(); asm volatile("" ::: "memory");
}
__device__ __forceinline__ float silu_f(float x) { return x * __builtin_amdgcn_rcpf(1.0f + __expf(-x)); }
__device__ __forceinline__ float logsig_f(float x) { return fminf(x, 0.0f) - __logf(1.0f + __expf(-fabsf(x))); }

struct EpiIn {
    static constexpr bool PERM = true, AFTER_DRAIN = false;
    bf16_t* Z; float* LA; const float* ssq; const float* b_alpha; PG8_LAS float* R; int nostore;
    __device__ __forceinline__ void prefetch(const Unit&, int) {}
    __device__ __forceinline__ void operator()(const f32x4 (&acc)[2][2][4][2], const Unit& u, int wr, int wc, int fr_, int fq_) const {
        int fr = fr_, fq = fq_; asm volatile("" : "+v"(fr), "+v"(fq));
        const int row0 = u.pm * BM + wr * 64 + fr, pn = u.pn, colw = wc * 32 + 8 * fq;
#pragma unroll
        for (int ai = 0; ai < 2; ++ai)
#pragma unroll
            for (int m = 0; m < 4; ++m) {
                const int row = row0 + ai * HALF + m * 16; const float rs = R[u.ui * BM + ai * HALF + wr * 64 + m * 16 + fr];
#pragma unroll
                for (int bj = 0; bj < 2; ++bj) {
                    f32x4 v0 = acc[ai][bj][m][0] * rs, v1 = acc[ai][bj][m][1] * rs; const int c = bj * HALF + colw;
                    if (pn == 9) {
                        const f32x4 b0 = *(const f32x4*)(b_alpha + c), b1 = *(const f32x4*)(b_alpha + c + 4);
#pragma unroll
                        for (int e = 0; e < 4; ++e) { v0[e] = logsig_f(v0[e] + b0[e]) * 0.0625f; v1[e] = logsig_f(v1[e] + b1[e]) * 0.0625f; }
                        u32x4 w; w.x = cvt_pk_bf16(v0[0], v0[1]); w.y = cvt_pk_bf16(v0[2], v0[3]); w.z = cvt_pk_bf16(v1[0], v1[1]); w.w = cvt_pk_bf16(v1[2], v1[3]);
                        if (!nostore) *(u32x4*)((bf16_t*)LA + (size_t)row * 256 + c) = w;
                    } else {
                        if (pn == 0) { v0 = v0 * 0.125f; v1 = v1 * 0.125f; }
                        else if (pn == 4 || pn == 5) {
#pragma unroll
                            for (int e = 0; e < 4; ++e) { v0[e] = silu_f(v0[e]); v1[e] = silu_f(v1[e]); } }
                        u32x4 w; w.x = cvt_pk_bf16(v0[0], v0[1]); w.y = cvt_pk_bf16(v0[2], v0[3]); w.z = cvt_pk_bf16(v1[0], v1[1]); w.w = cvt_pk_bf16(v1[2], v1[3]);
                        if (!nostore) *(u32x4*)(Z + (size_t)row * ZLD + pn * BM + c) = w;
                    }
                }
            }
    }
};

template <bool FINAL> struct EpiRes {
    static constexpr bool PERM = true, AFTER_DRAIN = false;
    bf16_t* XB; float* xout; float* ssq;
    u32x4 pre[2][2];
    __device__ __forceinline__ void prefetch(const Unit& u, int tid) {
        const int wid = tid >> 6, lane = tid & 63, wr = wid >> 2, wc = wid & 3, fr = lane & 15, fq = lane >> 4;
        const int row0 = u.pm * BM + wr * 64 + fr, col0 = u.pn * BM + wc * 32 + 8 * fq;
#pragma unroll
        for (int m = 0; m < 2; ++m)
#pragma unroll
            for (int bj = 0; bj < 2; ++bj) pre[m][bj] = *(const u32x4*)(XB + (size_t)(row0 + m * 16) * DM + col0 + bj * HALF);
    }
    __device__ __forceinline__ void operator()(const f32x4 (&acc)[2][2][4][2], const Unit& u, int wr, int wc, int fr_, int fq_) const {
        int fr = fr_, fq = fq_; asm volatile("" : "+v"(fr), "+v"(fq));
        const int row0 = u.pm * BM + wr * 64 + fr, col0 = u.pn * BM + wc * 32 + 8 * fq;
#pragma unroll
        for (int ai = 0; ai < 2; ++ai)
#pragma unroll
            for (int m = 0; m < 4; ++m) {
                const int row = row0 + ai * HALF + m * 16; float s = 0.f;
#pragma unroll
                for (int bj = 0; bj < 2; ++bj) {
                    const size_t off = (size_t)row * DM + col0 + bj * HALF;
                    const u32x4 r = (ai == 0 && m < 2) ? pre[m][bj] : *(const u32x4*)(XB + off);
                    f32x4 v0 = acc[ai][bj][m][0], v1 = acc[ai][bj][m][1];
                    v0[0] += __builtin_bit_cast(float, r.x << 16); v0[1] += __builtin_bit_cast(float, r.x & 0xffff0000u); v0[2] += __builtin_bit_cast(float, r.y << 16); v0[3] += __builtin_bit_cast(float, r.y & 0xffff0000u);
                    v1[0] += __builtin_bit_cast(float, r.z << 16); v1[1] += __builtin_bit_cast(float, r.z & 0xffff0000u); v1[2] += __builtin_bit_cast(float, r.w << 16); v1[3] += __builtin_bit_cast(float, r.w & 0xffff0000u);
                    if (FINAL) { *(f32x4*)(xout + off) = v0; *(f32x4*)(xout + off + 4) = v1; }
                    else {
                        u32x4 w; w.x = cvt_pk_bf16(v0[0], v0[1]); w.y = cvt_pk_bf16(v0[2], v0[3]); w.z = cvt_pk_bf16(v1[0], v1[1]); w.w = cvt_pk_bf16(v1[2], v1[3]);
                        *(u32x4*)(XB + off) = w;
                        s += ((v0[0] * v0[0] + v0[1] * v0[1]) + (v0[2] * v0[2] + v0[3] * v0[3])) + ((v1[0] * v1[0] + v1[1] * v1[1]) + (v1[2] * v1[2] + v1[3] * v1[3]));
                    }
                }
                if (!FINAL) { s += __shfl_xor(s, 16); s += __shfl_xor(s, 32);
                    if (fq == 0) ssq[(size_t)row * 16 + u.pn * 4 + wc] = s; }
            }
    }
};

template <int CTRL> __device__ __forceinline__ float dppz(float v) { return __builtin_bit_cast(float, __builtin_amdgcn_update_dpp(0, __builtin_bit_cast(int, v), CTRL, 0xf, 0xf, true)); }
template <int CTRL> __device__ __forceinline__ f32x4 dppz4(f32x4 v) { f32x4 r; r[0] = dppz<CTRL>(v[0]); r[1] = dppz<CTRL>(v[1]); r[2] = dppz<CTRL>(v[2]); r[3] = dppz<CTRL>(v[3]); return r; }
__device__ __forceinline__ void conv_taps(f32x4& uo, const f32x4& x, const f32x4& xp, const f32x4& w0, const f32x4& w1) {
    float u0 = uo[0], u1 = uo[1], u2 = uo[2], u3 = uo[3];
    asm volatile("s_nop 1\n\t"
        "v_fmac_f32_dpp %0, %4, %16 row_shr:1 row_mask:0xf bank_mask:0xf bound_ctrl:0\n\t"
        "v_fmac_f32_dpp %1, %5, %17 row_shr:1 row_mask:0xf bank_mask:0xf bound_ctrl:0\n\t"
        "v_fmac_f32_dpp %2, %6, %18 row_shr:1 row_mask:0xf bank_mask:0xf bound_ctrl:0\n\t"
        "v_fmac_f32_dpp %3, %7, %19 row_shr:1 row_mask:0xf bank_mask:0xf bound_ctrl:0\n\t"
        "v_fmac_f32_dpp %0, %4, %12 row_shr:2 row_mask:0xf bank_mask:0xf bound_ctrl:0\n\t"
        "v_fmac_f32_dpp %1, %5, %13 row_shr:2 row_mask:0xf bank_mask:0xf bound_ctrl:0\n\t"
        "v_fmac_f32_dpp %2, %6, %14 row_shr:2 row_mask:0xf bank_mask:0xf bound_ctrl:0\n\t"
        "v_fmac_f32_dpp %3, %7, %15 row_shr:2 row_mask:0xf bank_mask:0xf bound_ctrl:0\n\t"
        "v_fmac_f32_dpp %0, %8, %16 row_shl:15 row_mask:0xf bank_mask:0xf bound_ctrl:0\n\t"
        "v_fmac_f32_dpp %1, %9, %17 row_shl:15 row_mask:0xf bank_mask:0xf bound_ctrl:0\n\t"
        "v_fmac_f32_dpp %2, %10, %18 row_shl:15 row_mask:0xf bank_mask:0xf bound_ctrl:0\n\t"
        "v_fmac_f32_dpp %3, %11, %19 row_shl:15 row_mask:0xf bank_mask:0xf bound_ctrl:0\n\t"
        "v_fmac_f32_dpp %0, %8, %12 row_shl:14 row_mask:0xf bank_mask:0xf bound_ctrl:0\n\t"
        "v_fmac_f32_dpp %1, %9, %13 row_shl:14 row_mask:0xf bank_mask:0xf bound_ctrl:0\n\t"
        "v_fmac_f32_dpp %2, %10, %14 row_shl:14 row_mask:0xf bank_mask:0xf bound_ctrl:0\n\t"
        "v_fmac_f32_dpp %3, %11, %15 row_shl:14 row_mask:0xf bank_mask:0xf bound_ctrl:0"
        : "+v"(u0), "+v"(u1), "+v"(u2), "+v"(u3)
        : "v"(x[0]), "v"(x[1]), "v"(x[2]), "v"(x[3]), "v"(xp[0]), "v"(xp[1]), "v"(xp[2]), "v"(xp[3]),
          "v"(w0[0]), "v"(w0[1]), "v"(w0[2]), "v"(w0[3]), "v"(w1[0]), "v"(w1[1]), "v"(w1[2]), "v"(w1[3]));
    uo[0] = u0; uo[1] = u1; uo[2] = u2; uo[3] = u3;
}
struct EpiUp {
    static constexpr bool PERM = true, AFTER_DRAIN = false;
    bf16_t* ACT; const float* cw; const float* cb; float* HP; float* HC; PG8_LAS float* X; PG8_LAS float* R; PG8_LAS float* W;
    typedef float f32x2w __attribute__((ext_vector_type(2)));
    f32x2w pf;
    __device__ __forceinline__ void prefetch(const Unit& u, int tid) {
        const int t2 = tid * 2, k = t2 >> 8, gc = t2 & 255, oc = (gc >> 7) * FF + HALF * u.pn + (gc & 127);
        pf = *(const f32x2w*)((k < 3) ? cw + k * FF2 + oc : cb + oc);
    }
    __device__ __forceinline__ void operator()(const f32x4 (&acc)[2][2][4][2], const Unit& u, int wr, int wc, int fr_, int fq_) const {
        int fr = fr_, fq = fq_; asm volatile("" : "+v"(fr), "+v"(fq));
        *(PG8_LAS f32x2w*)(W + ((wr * 4 + wc) * 64 + fq * 16 + fr) * 2) = pf;
        const PG8_LAS float* Ru = R + u.ui * BM;
        const int rl0 = wr * 64 + fr;
        const int cint = wc * 32 + 8 * fq, oc0 = HALF * u.pn + cint, gc0 = BM * u.pn + cint;
        if (fr >= 14) {
#pragma unroll
            for (int ai = 0; ai < 2; ++ai) { const int q = 2 * ai + wr; const float rs3 = Ru[ai * HALF + rl0 + 48];
#pragma unroll
                for (int bj = 0; bj < 2; ++bj)
#pragma unroll
                    for (int n = 0; n < 2; ++n) *(PG8_LAS f32x4*)(X + ((q * 4 + wc) * 2 + (fr - 14)) * 64 + (bj * 2 + n) * 16 + fq * 4) = acc[ai][bj][3][n] * rs3; }
        }
        asm volatile("s_waitcnt lgkmcnt(0)" ::: "memory"); __builtin_amdgcn_s_barrier(); asm volatile("" ::: "memory");
#pragma unroll
        for (int ai = 0; ai < 2; ++ai) { const int q = 2 * ai + wr;
            float rs[4];
#pragma unroll
            for (int m = 0; m < 4; ++m) rs[m] = Ru[ai * HALF + rl0 + 16 * m];
#pragma unroll
            for (int n = 0; n < 2; ++n) {
                f32x4 ua[4];
#pragma unroll
                for (int bj = 0; bj < 2; ++bj) {
                    __builtin_amdgcn_sched_barrier(0);
                    const int lc = bj * HALF + cint + 4 * n;
                    const f32x4 w0 = *(const PG8_LAS f32x4*)(W + lc), w1 = *(const PG8_LAS f32x4*)(W + 256 + lc), w2 = *(const PG8_LAS f32x4*)(W + 512 + lc), bb = *(const PG8_LAS f32x4*)(W + 768 + lc);
                    f32x4 xp = (f32x4){0.f, 0.f, 0.f, 0.f};
                    if (q != 0) xp = *(const PG8_LAS f32x4*)(X + (((q - 1) * 4 + wc) * 2 + (fr & 1)) * 64 + (bj * 2 + n) * 16 + fq * 4);
#pragma unroll
                    for (int m = 0; m < 4; ++m) {
                        const f32x4 x = acc[ai][bj][m][n] * rs[m];
                        f32x4 uo = w2 * x + bb;
                        conv_taps(uo, x, xp, w0, w1);
                        xp = x;
                        if (m == 0) { if (q == 0 && fr < 2) *(f32x4*)(HP + ((size_t)u.pm * 2 + fr) * FF2 + gc0 + bj * HALF + 4 * n) = uo; }
                        if (m == 3) { if (q == 3) {
                            const f32x4 c1 = w1 * x + w0 * dppz4<0x111>(x);
                            if (fr == 15) { float* hp = HC + ((size_t)u.pm * 2) * FF2 + gc0 + bj * HALF + 4 * n; *(f32x4*)hp = w0 * x; *(f32x4*)(hp + FF2) = c1; } } }
                        if (bj == 0) ua[m] = uo;
                        else { const f32x4 a = ua[m];
                            typedef unsigned u32x2 __attribute__((ext_vector_type(2))); u32x2 w; w.x = cvt_pk_bf16(silu_f(a[0]) * uo[0], silu_f(a[1]) * uo[1]); w.y = cvt_pk_bf16(silu_f(a[2]) * uo[2], silu_f(a[3]) * uo[3]);
                            *(u32x2*)(ACT + (((size_t)u.pm * (FF / 64) + (oc0 >> 6)) * BM + ai * HALF + rl0 + 16 * m) * 64 + (oc0 & 63) + 4 * n) = w; }
                    }
                }
            }
        }
    }
};
template <class Epi, class Sched, bool ALIGN_EPI, bool SP2, int KC, bool ATILE = false>
__device__ __forceinline__ void gemm_phase(PG8_LAS unsigned char* lds, const Gemm g, const Sched& S, const Epi& E) {
    int tid_ = threadIdx.x; asm volatile("" : "+v"(tid_)); const int tid = tid_, wid = __builtin_amdgcn_readfirstlane(tid >> 6), lane = tid & 63, wr = wid >> 2, wc = wid & 3, fr = lane & 15, fq = lane >> 4;
    constexpr int K = KC, nt = K / BK;
    unsigned voffA[2], voffB[2];
#pragma unroll
    for (int i = 0; i < 2; ++i) { int R, C; stage_rc(tid * 16 + i * 8192, R, C); const int Rb = Epi::PERM ? ((R & ~31) + perm32(R & 31)) : R;
        voffA[i] = ATILE ? (unsigned)(R * BK + C) * 2u : (unsigned)(R * K + C) * 2u; voffB[i] = (unsigned)(Rb * K + C) * 2u; }
    const size_t kstep = (size_t)(BK * 2);
    const size_t hstep = (size_t)HALF * K * 2;
    const size_t tstep = 2 * hstep;
    const size_t kstepA = ATILE ? (size_t)(BM * BK * 2) : kstep, hstepA = ATILE ? (size_t)(HALF * BK * 2) : hstep, tstepA = ATILE ? (size_t)nt * (BM * BK * 2) : tstep;
    const unsigned ldsw = (unsigned)wid * 1024u;
    const int aoff = lds_byte(wr * 64 + fr, fq * 8), boff = lds_byte(wc * 32 + fr, fq * 8);
#define PG8_SA(b, h) (((b) * 2 + (h)) * HTB)
#define PG8_SB(b, h) ((4 + (b) * 2 + (h)) * HTB)
#define PG8_STAGE(bufoff, gbase, voff) do { _Pragma("unroll") for (int _i = 0; _i < 2; ++_i) \
        __builtin_amdgcn_global_load_lds((const unsigned*)((const char*)(gbase) + (voff)[_i]), (PG8_LAS unsigned*)(lds + (bufoff) + ldsw + _i * 8192), 16, 0, 0); } while (0)
#define PG8_LDA(dst, b, h) do { _Pragma("unroll") for (int m = 0; m < 4; ++m) _Pragma("unroll") for (int k = 0; k < 2; ++k) dst[m][k] = *(const PG8_LAS bf16x8*)(lds + PG8_SA(b, h) + aoff + m * 2048 + k * 1024); } while (0)
#define PG8_LDB(dst, b, h) do { _Pragma("unroll") for (int n = 0; n < 2; ++n) _Pragma("unroll") for (int k = 0; k < 2; ++k) dst[n][k] = *(const PG8_LAS bf16x8*)(lds + PG8_SB(b, h) + boff + n * 2048 + k * 1024); } while (0)
#define PG8_MMA(ai, bj, At, Bt) do { __builtin_amdgcn_s_setprio(1); _Pragma("unroll") for (int m = 0; m < 4; ++m) _Pragma("unroll") for (int n = 0; n < 2; ++n) _Pragma("unroll") for (int k = 0; k < 2; ++k) \
        acc[ai][bj][m][n] = __builtin_amdgcn_mfma_f32_16x16x32_bf16(Bt[n][k], At[m][k], acc[ai][bj][m][n], 0, 0, 0); __builtin_amdgcn_s_setprio(0); } while (0)
#define PG8_WAIT_V(n) asm volatile("s_waitcnt vmcnt(" #n ")" ::: "memory")
#define PG8_WAIT_L(n) asm volatile("s_waitcnt lgkmcnt(" #n ")" ::: "memory")
#define PG8_BAR __builtin_amdgcn_s_barrier()
#define PG8_SCHED __builtin_amdgcn_sched_barrier(0)
    Unit cur, nxt; int ui = 0; Epi EE = E;
    if (!S.next(0, cur)) return;
    f32x4 acc[2][2][4][2];
#pragma unroll
    for (int a = 0; a < 2; ++a)
#pragma unroll
        for (int b = 0; b < 2; ++b)
#pragma unroll
            for (int m = 0; m < 4; ++m)
#pragma unroll
                for (int n = 0; n < 2; ++n) acc[a][b][m][n] = (f32x4){0.f, 0.f, 0.f, 0.f};
    bf16x8 At[4][2], B0[2][2], B1[2][2];
    const char* cA = (const char*)g.A + (size_t)cur.pm * tstepA; const char* cB = (const char*)g.Bt + (size_t)cur.pn * tstep;
    S.a_ready(cur);
    if constexpr (SP2) {
        PG8_STAGE(PG8_SB(0, 0), cB, voffB); PG8_STAGE(PG8_SB(0, 1), cB + hstep, voffB); PG8_STAGE(PG8_SA(0, 0), cA, voffA); PG8_STAGE(PG8_SA(0, 1), cA + hstepA, voffA);
        if (wr == 1) PG8_BAR;
        PG8_WAIT_V(2); PG8_BAR;
        PG8_STAGE(PG8_SB(1, 0), cB + kstep, voffB); PG8_STAGE(PG8_SA(1, 0), cA + kstepA, voffA); PG8_STAGE(PG8_SB(1, 1), cB + hstep + kstep, voffB);
        PG8_WAIT_V(6); PG8_BAR;
    } else {
        PG8_STAGE(PG8_SB(0, 0), cB, voffB); PG8_STAGE(PG8_SA(0, 0), cA, voffA); PG8_STAGE(PG8_SB(0, 1), cB + hstep, voffB); PG8_STAGE(PG8_SA(0, 1), cA + hstepA, voffA);
        if (wr == 1) PG8_BAR;
        PG8_WAIT_V(4); PG8_BAR;
        PG8_STAGE(PG8_SB(1, 0), cB + kstep, voffB); PG8_STAGE(PG8_SA(1, 0), cA + kstepA, voffA); PG8_STAGE(PG8_SB(1, 1), cB + hstep + kstep, voffB);
        PG8_WAIT_V(6); PG8_BAR;
    }
    for (;;) {
        const bool has_next = S.next(ui + 1, nxt);
        const char* nA = has_next ? (const char*)g.A + (size_t)nxt.pm * tstepA : cA; const char* nB = has_next ? (const char*)g.Bt + (size_t)nxt.pn * tstep : cB;
        for (int t = 0; t < nt; t += 2) {
            const bool last = (t == nt - 2);
            const char* a1 = cA + (size_t)(t + 1) * kstepA;
            const char* a2 = last ? nA : cA + (size_t)(t + 2) * kstepA; const char* b2 = last ? nB : cB + (size_t)(t + 2) * kstep;
            const char* a3 = a2 + kstepA; const char* b3 = b2 + kstep;
            if (last && has_next) S.a_ready(nxt);
            if (last) EE.prefetch(cur, tid);
            if constexpr (SP2) {
            PG8_LDB(B0, 0, 0); PG8_LDB(B1, 0, 1); PG8_SCHED; PG8_LDA(At, 0, 0); PG8_STAGE(PG8_SA(1, 1), a1 + hstepA, voffA);
            PG8_WAIT_V(8); PG8_WAIT_L(0); PG8_BAR; PG8_MMA(0, 0, At, B0); PG8_MMA(0, 1, At, B1); PG8_BAR; PG8_SCHED;
            PG8_LDA(At, 0, 1); PG8_STAGE(PG8_SB(0, 0), b2, voffB); PG8_STAGE(PG8_SB(0, 1), b2 + hstep, voffB); PG8_STAGE(PG8_SA(0, 0), a2, voffA);
            PG8_WAIT_V(8); PG8_WAIT_L(0); PG8_BAR; PG8_MMA(1, 0, At, B0); PG8_MMA(1, 1, At, B1); PG8_BAR; PG8_SCHED;
            PG8_LDB(B0, 1, 0); PG8_LDB(B1, 1, 1); PG8_SCHED; PG8_LDA(At, 1, 0); PG8_STAGE(PG8_SA(0, 1), a2 + hstepA, voffA);
            PG8_WAIT_V(8); PG8_WAIT_L(0); PG8_BAR; PG8_MMA(0, 0, At, B0); PG8_MMA(0, 1, At, B1); PG8_BAR; PG8_SCHED;
            PG8_LDA(At, 1, 1); PG8_STAGE(PG8_SB(1, 0), b3, voffB); PG8_STAGE(PG8_SB(1, 1), b3 + hstep, voffB); PG8_STAGE(PG8_SA(1, 0), a3, voffA);
            PG8_WAIT_V(8); PG8_WAIT_L(0); PG8_BAR; PG8_MMA(1, 0, At, B0); PG8_MMA(1, 1, At, B1); PG8_BAR; PG8_SCHED;
            } else {
            PG8_LDB(B0, 0, 0); PG8_SCHED; PG8_LDA(At, 0, 0); PG8_STAGE(PG8_SA(1, 1), a1 + hstepA, voffA);
            PG8_WAIT_L(8); PG8_BAR; PG8_WAIT_L(0); PG8_MMA(0, 0, At, B0); PG8_BAR; PG8_SCHED;
            PG8_LDB(B1, 0, 1); PG8_STAGE(PG8_SB(0, 0), b2, voffB);
            PG8_BAR; PG8_WAIT_L(0); PG8_MMA(0, 1, At, B1); PG8_BAR;
            PG8_LDA(At, 0, 1); PG8_STAGE(PG8_SA(0, 0), a2, voffA);
            PG8_BAR; PG8_WAIT_L(0); PG8_MMA(1, 0, At, B0); PG8_BAR; PG8_SCHED;
            PG8_STAGE(PG8_SB(0, 1), b2 + hstep, voffB);
            PG8_WAIT_V(6); PG8_BAR; PG8_MMA(1, 1, At, B1); PG8_BAR;
            PG8_LDB(B0, 1, 0); PG8_SCHED; PG8_LDA(At, 1, 0); PG8_STAGE(PG8_SA(0, 1), a2 + hstepA, voffA);
            PG8_WAIT_L(8); PG8_BAR; PG8_WAIT_L(0); PG8_MMA(0, 0, At, B0); PG8_BAR; PG8_SCHED;
            PG8_LDB(B1, 1, 1); PG8_STAGE(PG8_SB(1, 0), b3, voffB);
            PG8_BAR; PG8_WAIT_L(0); PG8_MMA(0, 1, At, B1); PG8_BAR;
            PG8_LDA(At, 1, 1); PG8_STAGE(PG8_SA(1, 0), a3, voffA);
            PG8_BAR; PG8_WAIT_L(0); PG8_MMA(1, 0, At, B0); PG8_BAR; PG8_SCHED;
            PG8_STAGE(PG8_SB(1, 1), b3 + hstep, voffB);
            PG8_WAIT_V(6); PG8_BAR; PG8_MMA(1, 1, At, B1); PG8_BAR;
            }
        }
        if constexpr (ALIGN_EPI) { if (wr == 0) PG8_BAR; }
        if constexpr (!Epi::AFTER_DRAIN) { EE(acc, cur, wr, wc, fr, fq); S.done(cur); }
        if (!has_next) break;
#pragma unroll
        for (int a = 0; a < 2; ++a)
#pragma unroll
            for (int b = 0; b < 2; ++b)
#pragma unroll
                for (int m = 0; m < 4; ++m)
#pragma unroll
                    for (int n = 0; n < 2; ++n) acc[a][b][m][n] = (f32x4){0.f, 0.f, 0.f, 0.f};
        cur = nxt; cA = nA; cB = nB; ++ui;
        if constexpr (ALIGN_EPI) { if (wr == 1) PG8_BAR; }
    }
    PG8_WAIT_V(0);
    if constexpr (!ALIGN_EPI) { if (wr == 0) PG8_BAR; }
    PG8_BAR;
    if constexpr (Epi::AFTER_DRAIN) { E.fused(acc, cur, wr, wc, fr, fq, lds, wid, lane); S.done(cur); }
#undef PG8_SA
#undef PG8_SB
#undef PG8_STAGE
#undef PG8_LDA
#undef PG8_LDB
#undef PG8_MMA
#undef PG8_WAIT_V
#undef PG8_WAIT_L
#undef PG8_BAR
#undef PG8_SCHED
}
}

#define LAS __attribute__((address_space(3)))
typedef unsigned short bf16;
typedef float f32x4 __attribute__((ext_vector_type(4)));
typedef unsigned v4u __attribute__((ext_vector_type(4)));
typedef unsigned v2u __attribute__((ext_vector_type(2)));
constexpr int NB = 4, SEQ = 8192, D = 1024, T = NB * SEQ, DEPTH = 2;
constexpr int P_IN = 2320, N_IN = 2560, ZLD = 2304, FF = 2816, FF2 = 5632;
constexpr int ZQ = 0, ZK = 256, ZV = 512, ZR = 1024, ZSQ = 1536, ZSK = 2048, ZSV = 2176;
constexpr int NCHUNK = SEQ / 64, NUNIT = NB * 4 * NCHUNK;
constexpr float EPS = 1e-6f;
constexpr size_t MiB = 1u << 20;
constexpr size_t WS_WIN = 0, WS_WOUT = 10 * MiB, WS_WUP = 14 * MiB, WS_WDN = 36 * MiB, WS_SSQ = 47 * MiB, WS_HP = 49 * MiB, WS_HC = 55 * MiB, WS_DEC = 61 * MiB,
                 WS_XB = 62 * MiB, WS_OMIX = 126 * MiB, WS_Z = 190 * MiB, WS_LA = 334 * MiB, WS_ACT = 190 * MiB, WS_ST = 366 * MiB, WS_SP = 430 * MiB, WS_CTL = 462 * MiB, WS_END = 463 * MiB;
constexpr size_t CTL_ZERO_BYTES = 16384;
constexpr int LDS_BYTES = 157696, XOFF = 131072, RALL_OFF = 145408;

#define LDS_WAIT() asm volatile("s_waitcnt lgkmcnt(0)" ::: "memory")
#define LDSBAR() do { asm volatile("s_waitcnt lgkmcnt(0)" ::: "memory"); __builtin_amdgcn_s_barrier(); asm volatile("" ::: "memory"); } while (0)
__device__ __forceinline__ unsigned f2bf(float f) { unsigned u = __builtin_bit_cast(unsigned, f); return (u + 0x7fffu + ((u >> 16) & 1u)) >> 16; }
__device__ __forceinline__ unsigned pk2(float lo, float hi) { return f2bf(lo) | (f2bf(hi) << 16); }
__device__ __forceinline__ float bf2f(unsigned short h) { return __builtin_bit_cast(float, (unsigned)h << 16); }
__device__ __forceinline__ float bflo(unsigned w) { return __builtin_bit_cast(float, w << 16); }
__device__ __forceinline__ float bfhi(unsigned w) { return __builtin_bit_cast(float, w & 0xffff0000u); }
__device__ __forceinline__ float wave_sum(float v) {
#pragma unroll
    for (int o = 1; o < 64; o <<= 1) v += __shfl_xor(v, o);
    return v;
}
__device__ __forceinline__ float silu_f(float x) { return x * __builtin_amdgcn_rcpf(1.0f + __expf(-x)); }


typedef short bf16x8 __attribute__((ext_vector_type(8)));
__device__ __forceinline__ bf16x8 mk8(unsigned a, unsigned b, unsigned c, unsigned d) { v4u w; w.x = a; w.y = b; w.z = c; w.w = d; return __builtin_bit_cast(bf16x8, w); }
__device__ __forceinline__ f32x4 mfma16(bf16x8 x, bf16x8 y, f32x4 c) { return __builtin_amdgcn_mfma_f32_16x16x32_bf16(x, y, c, 0, 0, 0); }
typedef float f32x2_t __attribute__((ext_vector_type(2)));
typedef __bf16 bf16x2_t __attribute__((ext_vector_type(2)));
__device__ __forceinline__ unsigned cvtpk(float lo, float hi) { f32x2_t v = {lo, hi}; bf16x2_t b = __builtin_convertvector(v, bf16x2_t); return __builtin_bit_cast(unsigned, b); }

struct Args { const float* in[15]; float* out; unsigned char* ws; };

typedef const __attribute__((address_space(4))) char* kptr_t;
__device__ __forceinline__ kptr_t kargp() { kptr_t kp = (kptr_t)__builtin_amdgcn_kernarg_segment_ptr(); asm volatile("" : "+s"(kp)); return kp; }
__device__ __forceinline__ const float* arg_in(int i) { return *(const float* const __attribute__((address_space(4)))*)(kargp() + 8 * i); }
__device__ __forceinline__ float* arg_out() { return *(float* const __attribute__((address_space(4)))*)(kargp() + 8 * 15); }
__device__ __forceinline__ unsigned char* arg_ws() { return *(unsigned char* const __attribute__((address_space(4)))*)(kargp() + 8 * 16); }
__device__ __forceinline__ unsigned char* wsp(const Args& a) { unsigned char* p = a.ws; asm volatile("" : "+s"(p)); return p; }

template <class Src> __device__ __forceinline__ void tr_item(Src src, int K, bf16* WT, int nblk, LAS float* scr, int item, int lane) {
    const int kb = item / nblk, nb = item % nblk, k0 = 64 * kb, n0 = 32 * nb;
#pragma unroll 8
    for (int i = 0; i < 32; ++i) { const int kk = 2 * i + (lane >> 5); scr[kk * 33 + (lane & 31)] = src(k0 + kk, n0 + (lane & 31)); }
    LDS_WAIT(); asm volatile("" ::: "memory");
    const int c = lane & 7;
#pragma unroll
    for (int j = 0; j < 4; ++j) { const int n = (lane >> 3) + 8 * j; const LAS float* s = scr + (8 * c) * 33 + n;
        v4u o; o.x = pk2(s[0 * 33], s[1 * 33]); o.y = pk2(s[2 * 33], s[3 * 33]); o.z = pk2(s[4 * 33], s[5 * 33]); o.w = pk2(s[6 * 33], s[7 * 33]);
        *(v4u*)(WT + (size_t)(n0 + n) * K + k0 + 8 * c) = o; }
    LDS_WAIT(); asm volatile("" ::: "memory");
}

__device__ __forceinline__ void tr_item16(const float* Wsrc, int ldw, const float* g, int K, bf16* WT, int k0, int n0, LAS float* scr, int lane) {
    const int r8 = lane >> 3, c4 = lane & 7;
#pragma unroll
    for (int i = 0; i < 8; ++i) { const int kk = 8 * i + r8; const f32x4 v = *(const f32x4*)(Wsrc + (size_t)(k0 + kk) * ldw + 4 * c4); const float gk = g ? g[k0 + kk] : 1.0f;
        LAS float* s = scr + kk * 33 + 4 * c4; s[0] = v[0] * gk; s[1] = v[1] * gk; s[2] = v[2] * gk; s[3] = v[3] * gk; }
    LDS_WAIT(); asm volatile("" ::: "memory");
    const int c = lane & 7;
#pragma unroll
    for (int j = 0; j < 4; ++j) { const int n = (lane >> 3) + 8 * j; const LAS float* s = scr + (8 * c) * 33 + n;
        v4u o; o.x = pk2(s[0 * 33], s[1 * 33]); o.y = pk2(s[2 * 33], s[3 * 33]); o.z = pk2(s[4 * 33], s[5 * 33]); o.w = pk2(s[6 * 33], s[7 * 33]);
        *(v4u*)(WT + (size_t)(n0 + n) * K + k0 + 8 * c) = o; }
    LDS_WAIT(); asm volatile("" ::: "memory");
}

__device__ __forceinline__ void p0_prologue(const Args& a, LAS unsigned char* lds, int G) {
    unsigned char* const wsx = arg_ws();
    int tid_ = threadIdx.x; asm volatile("" : "+v"(tid_)); const int tid = tid_, lane = tid & 63, wave = tid >> 6;
    LAS float* scr = (LAS float*)(lds + wave * 16384);
    const int gw = blockIdx.x * 8 + wave, NGW = G * 8;
    constexpr int I_IN = 16 * (N_IN / 32), I_OUT = 16 * (D / 32), I_UP = 16 * (FF2 / 32), I_DN = (FF / 64) * (D / 32), I_L = I_IN + I_OUT + I_UP + I_DN;
    for (int it = gw; it < DEPTH * I_L; it += NGW) {
        const int l = it / I_L; int r = it % I_L;
        if (r < I_IN) {
            const float* W = arg_in(2) + (size_t)l * D * P_IN; const float* g = arg_in(1) + l * D; const float* wa2 = arg_in(3) + l * 16 * 256;
            bf16* WT = (bf16*)(wsx + WS_WIN) + (size_t)l * N_IN * D;
            { const int nblk_ = N_IN / 32, kb_ = r / nblk_, nb_ = r % nblk_, n0_ = 32 * nb_;
              if (n0_ < 2304) { tr_item16(W + (n0_ < 1536 ? n0_ : n0_ + 16), P_IN, g, D, WT, 64 * kb_, n0_, scr, lane); continue; } }
            tr_item([=](int k, int n) -> float {
                const float gk = g[k];
                if (n < 2304) return W[(size_t)k * P_IN + (n < 1536 ? n : n + 16)] * gk;
                float s = 0.f; const float* wr = W + (size_t)k * P_IN + 1536; const int c = n - 2304;
#pragma unroll
                for (int q = 0; q < 16; ++q) s += wr[q] * wa2[q * 256 + c];
                return s * gk; }, D, WT, N_IN / 32, scr, r, lane);
            continue; }
        r -= I_IN;
        if (r < I_OUT) { const float* W = arg_in(9) + (size_t)l * D * D; bf16* WT = (bf16*)(wsx + WS_WOUT) + (size_t)l * D * D;
            { const int nblk_ = D / 32, kb_ = r / nblk_, nb_ = r % nblk_; tr_item16(W + 32 * nb_, D, nullptr, D, WT, 64 * kb_, 32 * nb_, scr, lane); } continue; }
        r -= I_OUT;
        if (r < I_UP) { const float* W = arg_in(11) + (size_t)l * D * FF2; const float* g = arg_in(10) + l * D; bf16* WT = (bf16*)(wsx + WS_WUP) + (size_t)l * FF2 * D;
            { const int nblk_ = FF2 / 32, kb_ = r / nblk_, nb_ = r % nblk_, n0_ = 32 * nb_, pn_ = n0_ >> 8, bj_ = (n0_ >> 7) & 1, j_ = n0_ & 127;
              tr_item16(W + bj_ * FF + 128 * pn_ + j_, FF2, g, D, WT, 64 * kb_, n0_, scr, lane); } continue; }
        r -= I_UP;
        { const float* W = arg_in(14) + (size_t)l * FF * D; bf16* WT = (bf16*)(wsx + WS_WDN) + (size_t)l * D * FF;
            { const int nblk_ = D / 32, kb_ = r / nblk_, nb_ = r % nblk_; tr_item16(W + 32 * nb_, D, nullptr, FF, WT, 64 * kb_, 32 * nb_, scr, lane); } }
    }
    const float* x = arg_in(0); bf16* XB = (bf16*)(wsx + WS_XB); float* SSQ = (float*)(wsx + WS_SSQ);
    for (int m = gw; m < T; m += NGW) {
        const f32x4* xr = (const f32x4*)(x + (size_t)m * D) + lane; f32x4 v[4]; float s = 0.f;
#pragma unroll
        for (int j = 0; j < 4; ++j) { v[j] = xr[64 * j]; s += (v[j][0] * v[j][0] + v[j][1] * v[j][1]) + (v[j][2] * v[j][2] + v[j][3] * v[j][3]); }
        s = wave_sum(s);
        v2u* o8 = (v2u*)(XB + (size_t)m * D) + lane;
#pragma unroll
        for (int j = 0; j < 4; ++j) { v2u w; w.x = pk2(v[j][0], v[j][1]); w.y = pk2(v[j][2], v[j][3]); o8[64 * j] = w; }
        if (lane < 16) SSQ[(size_t)m * 16 + lane] = (lane == 0) ? s : 0.f;
    }
}

__device__ __forceinline__ void gla_a_phase(const Args& a, LAS unsigned char* lds, int G) {
    unsigned char* const wsx = arg_ws();
    int tid_ = threadIdx.x; asm volatile("" : "+v"(tid_)); const int tid = tid_, hw = tid >> 8, t = tid & 255, d = t & 63, seg = t >> 6, segs = __builtin_amdgcn_readfirstlane(seg);
    LAS unsigned char* base = lds + hw * 40960;
    LAS float* tot = (LAS float*)base; LAS bf16* kdT = (LAS bf16*)(base + 1024); LAS bf16* vT = (LAS bf16*)(base + 10240);
    const bf16* Z = (const bf16*)(wsx + WS_Z); const float* LA = (const float*)(wsx + WS_LA); bf16* ST = (bf16*)(wsx + WS_ST); float* DEC = (float*)(wsx + WS_DEC);
    const int dp = t & 31, rg = t >> 5, d0 = 2 * dp;
    LAS float* tot2 = (LAS float*)(base + 28672);
    f32x2_t lav[8]; unsigned kraw[8]; v4u vw[4];
#define GA_LOAD(pp) do { const int unit_ = 2 * (pp) + hw, n_ = unit_ & (NCHUNK - 1), bh_ = unit_ >> 7, h_ = bh_ & 3, b_ = bh_ >> 2, tok_ = b_ * SEQ + n_ * 64; \
        _Pragma("unroll") for (int i = 0; i < 8; ++i) { const size_t row_ = (size_t)(tok_ + 8 * rg + i); { const unsigned lw_ = *(const unsigned*)((const bf16*)LA + row_ * 256 + h_ * 64 + d0); lav[i] = (f32x2_t){bflo(lw_), bfhi(lw_)}; } kraw[i] = *(const unsigned*)(Z + row_ * ZLD + ZK + h_ * 64 + d0); } \
        _Pragma("unroll") for (int it = 0; it < 4; ++it) { const int id = t + 256 * (it >> 1), row = 2 * (id >> 4) + (it & 1), cg8 = id & 15; vw[it] = *(const v4u*)(Z + (size_t)(tok_ + row) * ZLD + ZV + h_ * 128 + 8 * cg8); } } while (0)
    if ((int)blockIdx.x < NUNIT / 2) GA_LOAD((int)blockIdx.x);
    for (int p = blockIdx.x; p < NUNIT / 2; p += G) {
        const int unit = 2 * p + hw, n = unit & (NCHUNK - 1), bh = unit >> 7, h = bh & 3, b = bh >> 2;
        const int tok0 = b * SEQ + n * 64;
        float b0[8], b1[8]; float r0 = 0.f, r1 = 0.f;
#pragma unroll
        for (int i = 0; i < 8; ++i) { r0 += lav[i].x; b0[i] = r0; r1 += lav[i].y; b1[i] = r1; }
        *(LAS f32x2_t*)(tot2 + rg * 64 + d0) = (f32x2_t){r0, r1};
        LDSBAR();
        float o0 = 0.f, o1 = 0.f, bl0 = 0.f, bl1 = 0.f;
#pragma unroll
        for (int s = 0; s < 8; ++s) { const f32x2_t tv = *(const LAS f32x2_t*)(tot2 + s * 64 + d0); bl0 += tv.x; bl1 += tv.y; if (s < rg) { o0 += tv.x; o1 += tv.y; } }
        { float k0[8], k1[8];
#pragma unroll
          for (int i = 0; i < 8; ++i) { k0[i] = bflo(kraw[i]) * __expf(bl0 - (b0[i] + o0)); k1[i] = bfhi(kraw[i]) * __expf(bl1 - (b1[i] + o1)); }
          v4u w0, w1; w0.x = cvtpk(k0[0], k0[1]); w0.y = cvtpk(k0[2], k0[3]); w0.z = cvtpk(k0[4], k0[5]); w0.w = cvtpk(k0[6], k0[7]); w1.x = cvtpk(k1[0], k1[1]); w1.y = cvtpk(k1[2], k1[3]); w1.z = cvtpk(k1[4], k1[5]); w1.w = cvtpk(k1[6], k1[7]);
          *(LAS v4u*)(kdT + d0 * 72 + 8 * rg) = w0; *(LAS v4u*)(kdT + (d0 + 1) * 72 + 8 * rg) = w1; }
        if (rg == 0) *(f32x2_t*)(DEC + (size_t)unit * 64 + d0) = (f32x2_t){__expf(bl0), __expf(bl1)};
#pragma unroll
        for (int it = 0; it < 2; ++it) { const int id = t + 256 * it, rp = id >> 4, cg8 = id & 15;
            const v4u w0 = vw[2 * it], w1 = vw[2 * it + 1];
            LAS unsigned* vp = (LAS unsigned*)(vT + (8 * cg8) * 72 + 2 * rp);
            vp[0 * 36] = (w0.x & 0xffff) | (w1.x << 16); vp[1 * 36] = (w0.x >> 16) | (w1.x & 0xffff0000u); vp[2 * 36] = (w0.y & 0xffff) | (w1.y << 16); vp[3 * 36] = (w0.y >> 16) | (w1.y & 0xffff0000u);
            vp[4 * 36] = (w0.z & 0xffff) | (w1.z << 16); vp[5 * 36] = (w0.z >> 16) | (w1.z & 0xffff0000u); vp[6 * 36] = (w0.w & 0xffff) | (w1.w << 16); vp[7 * 36] = (w0.w >> 16) | (w1.w & 0xffff0000u); }
        LDSBAR();
        if (p + G < NUNIT / 2) GA_LOAD(p + G);
        {
            const int fr = t & 15, fq = (t >> 4) & 3;
            bf16x8 Xk[2];
#pragma unroll
            for (int ks = 0; ks < 2; ++ks) Xk[ks] = *(const LAS bf16x8*)(kdT + (16 * seg + fr) * 72 + 32 * ks + 8 * fq);
#pragma unroll
            for (int vb = 0; vb < 8; ++vb) { f32x4 acc = (f32x4){0.f, 0.f, 0.f, 0.f};
#pragma unroll
                for (int ks = 0; ks < 2; ++ks) acc = mfma16(Xk[ks], *(const LAS bf16x8*)(vT + (16 * vb + fr) * 72 + 32 * ks + 8 * fq), acc);
                v2u sw; sw.x = cvtpk(acc[0], acc[1]); sw.y = cvtpk(acc[2], acc[3]); *(v2u*)(ST + (size_t)unit * 8192 + (16 * vb + fr) * 64 + 16 * seg + 4 * fq) = sw; }
        }
        LDSBAR();
    }
#undef GA_LOAD
}

__device__ __forceinline__ void gla_scan_phase(const Args& a, int G) {
    unsigned char* const wsx = arg_ws();
    const unsigned* ST = (const unsigned*)(wsx + WS_ST); const float* DEC = (const float*)(wsx + WS_DEC); unsigned* SP = (unsigned*)(wsx + WS_SP);
    int tid_ = threadIdx.x; asm volatile("" : "+v"(tid_));
    if (tid_ >= 256) return;
    for (int e = blockIdx.x * 256 + tid_; e < 16 * 4096; e += G * 256) {
        const int bh = e >> 12, ep = e & 4095, d = (2 * ep) & 63; float S0 = 0.f, S1 = 0.f;
        const unsigned* stp = ST + (size_t)bh * NCHUNK * 4096 + ep; const float* dp = DEC + (size_t)bh * NCHUNK * 64 + d; unsigned* sp = SP + (size_t)bh * NCHUNK * 4096 + ep;
#pragma unroll 1
        for (int n0 = 0; n0 < NCHUNK; n0 += 32) {
            unsigned cs[32]; float d0[32], d1[32];
#pragma unroll
            for (int j = 0; j < 32; ++j) { cs[j] = stp[(size_t)(n0 + j) * 4096]; const f32x2_t dd = *(const f32x2_t*)(dp + (n0 + j) * 64); d0[j] = dd.x; d1[j] = dd.y; }
#pragma unroll
            for (int j = 0; j < 32; ++j) { sp[(size_t)(n0 + j) * 4096] = cvtpk(S0, S1); S0 = S0 * d0[j] + bflo(cs[j]); S1 = S1 * d1[j] + bfhi(cs[j]); }
        }
    }
}

__device__ __forceinline__ void gla_c_phase(const Args& a, int l, LAS unsigned char* lds, int G) {
    unsigned char* const wsx = arg_ws();
    int tid_ = threadIdx.x; asm volatile("" : "+v"(tid_)); const int tid = tid_, hw = tid >> 8, t = tid & 255, d = t & 63, seg = t >> 6, segs = __builtin_amdgcn_readfirstlane(seg);
    LAS unsigned char* base = lds + hw * 65536;
    LAS float* tot = (LAS float*)base; LAS bf16* qe = (LAS bf16*)(base + 1024); LAS bf16* ke = (LAS bf16*)(base + 10240); LAS bf16* vT = (LAS bf16*)(base + 19456);
    LAS float* Am = (LAS float*)(base + 37888); LAS float* rsum = (LAS float*)(base + 54528);
    const bf16* Z = (const bf16*)(wsx + WS_Z); const float* LA = (const float*)(wsx + WS_LA); const bf16* SP = (const bf16*)(wsx + WS_SP); bf16* OMIX = (bf16*)(wsx + WS_OMIX);
    const float* gnorm = arg_in(5) + l * 128;
    LAS float* gnl = (LAS float*)(lds + 131072);
    if (tid < 128) gnl[tid] = gnorm[tid];
    LDSBAR();
    const int dp = t & 31, rg = t >> 5, d0 = 2 * dp;
    LAS float* tot2 = (LAS float*)(base + 37888);
    f32x2_t lav[8]; unsigned qraw[8], kraw[8]; v4u vw[4];
#define GC_LOAD(pp) do { const int unit_ = 2 * (pp) + hw, n_ = unit_ & (NCHUNK - 1), bh_ = unit_ >> 7, h_ = bh_ & 3, b_ = bh_ >> 2, tok_ = b_ * SEQ + n_ * 64; \
        _Pragma("unroll") for (int i = 0; i < 8; ++i) { const size_t row_ = (size_t)(tok_ + 8 * rg + i); { const unsigned lw_ = *(const unsigned*)((const bf16*)LA + row_ * 256 + h_ * 64 + d0); lav[i] = (f32x2_t){bflo(lw_), bfhi(lw_)}; } qraw[i] = *(const unsigned*)(Z + row_ * ZLD + ZQ + h_ * 64 + d0); kraw[i] = *(const unsigned*)(Z + row_ * ZLD + ZK + h_ * 64 + d0); } \
        _Pragma("unroll") for (int it = 0; it < 4; ++it) { const int id = t + 256 * (it >> 1), row = 2 * (id >> 4) + (it & 1), cg8 = id & 15; vw[it] = *(const v4u*)(Z + (size_t)(tok_ + row) * ZLD + ZV + h_ * 128 + 8 * cg8); } } while (0)
    if ((int)blockIdx.x < NUNIT / 2) GC_LOAD((int)blockIdx.x);
    for (int p = blockIdx.x; p < NUNIT / 2; p += G) {
        const int unit = 2 * p + hw, n = unit & (NCHUNK - 1), bh = unit >> 7, h = bh & 3, b = bh >> 2;
        const int tok0 = b * SEQ + n * 64;
        bf16x8 Xs[8][2]; v2u grw[8];
        { const int fr = t & 15, fq = (t >> 4) & 3;
#pragma unroll
          for (int vb = 0; vb < 8; ++vb) {
#pragma unroll
              for (int ks = 0; ks < 2; ++ks) Xs[vb][ks] = *(const bf16x8*)(SP + (size_t)unit * 8192 + (32 * (vb >> 1) + 8 * (fr >> 2) + 4 * (vb & 1) + (fr & 3)) * 64 + 32 * ks + 8 * fq);
              grw[vb] = *(const v2u*)(Z + (size_t)(tok0 + 16 * seg + fr) * ZLD + ZR + h * 128 + 32 * (vb >> 1) + 8 * fq + 4 * (vb & 1)); } }
        float b0[8], b1[8]; float r0 = 0.f, r1 = 0.f;
#pragma unroll
        for (int i = 0; i < 8; ++i) { r0 += lav[i].x; b0[i] = r0; r1 += lav[i].y; b1[i] = r1; }
        *(LAS f32x2_t*)(tot2 + rg * 64 + d0) = (f32x2_t){r0, r1};
        LDSBAR();
        float o0 = 0.f, o1 = 0.f;
#pragma unroll
        for (int s = 0; s < 8; ++s) { const f32x2_t tv = *(const LAS f32x2_t*)(tot2 + s * 64 + d0); if (s < rg) { o0 += tv.x; o1 += tv.y; } }
#pragma unroll
        for (int i = 0; i < 8; ++i) { const int c = 8 * rg + i; const float bb0 = b0[i] + o0, bb1 = b1[i] + o1;
            *(LAS unsigned*)(qe + c * 72 + d0) = cvtpk(bflo(qraw[i]) * __expf(bb0), bfhi(qraw[i]) * __expf(bb1));
            *(LAS unsigned*)(ke + c * 72 + d0) = cvtpk(bflo(kraw[i]) * __expf(-bb0), bfhi(kraw[i]) * __expf(-bb1)); }
#pragma unroll
        for (int it = 0; it < 2; ++it) { const int id = t + 256 * it, rp = id >> 4, cg8 = id & 15;
            const v4u w0 = vw[2 * it], w1 = vw[2 * it + 1];
            LAS unsigned* vp = (LAS unsigned*)(vT + (8 * cg8) * 72 + 2 * rp);
            vp[0 * 36] = (w0.x & 0xffff) | (w1.x << 16); vp[1 * 36] = (w0.x >> 16) | (w1.x & 0xffff0000u); vp[2 * 36] = (w0.y & 0xffff) | (w1.y << 16); vp[3 * 36] = (w0.y >> 16) | (w1.y & 0xffff0000u);
            vp[4 * 36] = (w0.z & 0xffff) | (w1.z << 16); vp[5 * 36] = (w0.z >> 16) | (w1.z & 0xffff0000u); vp[6 * 36] = (w0.w & 0xffff) | (w1.w << 16); vp[7 * 36] = (w0.w >> 16) | (w1.w & 0xffff0000u); }
        LDSBAR();
        if (p + G < NUNIT / 2) GC_LOAD(p + G);
        {
            const int fr = t & 15, fq = (t >> 4) & 3;
            bf16x8 Yq[2];
#pragma unroll
            for (int ks = 0; ks < 2; ++ks) Yq[ks] = *(const LAS bf16x8*)(qe + (16 * seg + fr) * 72 + 32 * ks + 8 * fq);
            f32x4 sc[4];
#pragma unroll
            for (int sb = 0; sb < 4; ++sb) { sc[sb] = (f32x4){0.f, 0.f, 0.f, 0.f};
                if (sb <= segs) {
#pragma unroll
                    for (int ks = 0; ks < 2; ++ks) sc[sb] = mfma16(*(const LAS bf16x8*)(ke + (16 * sb + fr) * 72 + 32 * ks + 8 * fq), Yq[ks], sc[sb]);
                    if (sb == segs) {
#pragma unroll
                        for (int e = 0; e < 4; ++e) sc[sb][e] = (4 * fq + e <= fr) ? sc[sb][e] : 0.f; }
                } }
            f32x4 o[8];
#pragma unroll
            for (int vb = 0; vb < 8; ++vb) o[vb] = (f32x4){0.f, 0.f, 0.f, 0.f};
#pragma unroll
            for (int k2 = 0; k2 < 2; ++k2) {
                if (2 * k2 <= segs) {
                    const bf16x8 P = mk8(cvtpk(sc[2 * k2][0], sc[2 * k2][1]), cvtpk(sc[2 * k2][2], sc[2 * k2][3]), cvtpk(sc[2 * k2 + 1][0], sc[2 * k2 + 1][1]), cvtpk(sc[2 * k2 + 1][2], sc[2 * k2 + 1][3]));
#pragma unroll
                    for (int vb = 0; vb < 8; ++vb) { const LAS bf16* vp = vT + (32 * (vb >> 1) + 8 * (fr >> 2) + 4 * (vb & 1) + (fr & 3)) * 72 + 32 * k2 + 4 * fq;
                        const v2u lo = *(const LAS v2u*)vp, hi = *(const LAS v2u*)(vp + 16);
                        o[vb] = mfma16(mk8(lo.x, lo.y, hi.x, hi.y), P, o[vb]); }
                } }
#pragma unroll
            for (int ks = 0; ks < 2; ++ks)
#pragma unroll
                for (int vb = 0; vb < 8; ++vb) o[vb] = mfma16(Xs[vb][ks], Yq[ks], o[vb]);
            float ss = 0.f;
#pragma unroll
            for (int vb = 0; vb < 8; ++vb) ss += (o[vb][0] * o[vb][0] + o[vb][1] * o[vb][1]) + (o[vb][2] * o[vb][2] + o[vb][3] * o[vb][3]);
            ss += __shfl_xor(ss, 16); ss += __shfl_xor(ss, 32);
            const float r = rsqrtf(ss * (1.0f / 128.0f) + EPS);
            const size_t tok = (size_t)(tok0 + 16 * seg + fr);
#pragma unroll
            for (int vp2 = 0; vp2 < 4; ++vp2) { const int vc = 32 * vp2 + 8 * fq;
                const v2u g0 = grw[2 * vp2], g1 = grw[2 * vp2 + 1]; const f32x4 n0 = *(const LAS f32x4*)(gnl + vc), n1 = *(const LAS f32x4*)(gnl + vc + 4);
                const f32x4 oa = o[2 * vp2], ob = o[2 * vp2 + 1];
                v4u w; w.x = cvtpk(oa[0] * r * n0[0] * bflo(g0.x), oa[1] * r * n0[1] * bfhi(g0.x)); w.y = cvtpk(oa[2] * r * n0[2] * bflo(g0.y), oa[3] * r * n0[3] * bfhi(g0.y));
                w.z = cvtpk(ob[0] * r * n1[0] * bflo(g1.x), ob[1] * r * n1[1] * bfhi(g1.x)); w.w = cvtpk(ob[2] * r * n1[2] * bflo(g1.y), ob[3] * r * n1[3] * bfhi(g1.y));
                *(v4u*)(OMIX + tok * D + h * 128 + vc) = w; }
        }
        LDSBAR();
    }
#undef GC_LOAD
}

__device__ __forceinline__ void swa_phase(const Args& a, int l, LAS unsigned char* lds, int G) {
    unsigned char* const wsx = arg_ws();
    int tid_ = threadIdx.x; asm volatile("" : "+v"(tid_)); const int tid = tid_, lane = tid & 63, w = tid >> 6, fr0 = lane & 15, fq0 = lane >> 4;
    LAS bf16* Kn = (LAS bf16*)lds; LAS bf16* vT = (LAS bf16*)(lds + 36864);
    const bf16* Z = (const bf16*)(wsx + WS_Z); bf16* OMIX = (bf16*)(wsx + WS_OMIX);
    const float* qn = arg_in(6) + l * 64; const float* kn = arg_in(7) + l * 64; const float* sinks = arg_in(8) + l * 8;
    constexpr float LOG2E = 1.4426950408889634f;
    for (int unit = blockIdx.x; unit < NB * 64 * 2; unit += G) {
        const int kvh = unit & 1, nbk = (unit >> 1) & 63, b = unit >> 7;
        v4u qn0, qn1;
        { const size_t tq = (size_t)b * SEQ + nbk * 128 + 16 * w + fr0; qn0 = *(const v4u*)(Z + tq * ZLD + ZSQ + kvh * 256 + 8 * fq0); qn1 = *(const v4u*)(Z + tq * ZLD + ZSQ + kvh * 256 + 32 + 8 * fq0); }
#ifdef PROBE_SWA_STAGE
        for (int rep_ = 0; rep_ < 2; ++rep_) { if (rep_) LDSBAR();
#endif
        {
            const int j = tid >> 1, hf = tid & 1; int tok = b * SEQ + (nbk - 1) * 128 + j; if (tok < b * SEQ) tok = b * SEQ;
            const v4u* kp = (const v4u*)(Z + (size_t)tok * ZLD + ZSK + kvh * 64 + hf * 32);
            const int jp = tid >> 2, qd = tid & 3; int tv = b * SEQ + (nbk - 1) * 128 + 2 * jp; if (tv < b * SEQ) tv = b * SEQ;
            const v4u* vp0 = (const v4u*)(Z + (size_t)tv * ZLD + ZSV + kvh * 64 + qd * 16); const v4u* vp1 = (const v4u*)(Z + (size_t)(tv + 1) * ZLD + ZSV + kvh * 64 + qd * 16);
            v4u kw[4], va[2], vb[2];
#pragma unroll
            for (int c = 0; c < 4; ++c) kw[c] = kp[c];
            va[0] = vp0[0]; va[1] = vp0[1]; vb[0] = vp1[0]; vb[1] = vp1[1];
            float ss = 0.f;
#pragma unroll
            for (int c = 0; c < 4; ++c) { const float e0 = bflo(kw[c].x), e1 = bfhi(kw[c].x), e2 = bflo(kw[c].y), e3 = bfhi(kw[c].y), e4 = bflo(kw[c].z), e5 = bfhi(kw[c].z), e6 = bflo(kw[c].w), e7 = bfhi(kw[c].w);
                ss += ((e0 * e0 + e1 * e1) + (e2 * e2 + e3 * e3)) + ((e4 * e4 + e5 * e5) + (e6 * e6 + e7 * e7)); }
            ss += __shfl_xor(ss, 1);
            const float r = rsqrtf(ss * (1.0f / 64.0f) + EPS);
#pragma unroll
            for (int c = 0; c < 4; ++c) { const f32x4 g0 = *(const f32x4*)(kn + hf * 32 + 8 * c), g1 = *(const f32x4*)(kn + hf * 32 + 8 * c + 4);
                v4u o; o.x = cvtpk(bflo(kw[c].x) * r * g0[0], bfhi(kw[c].x) * r * g0[1]); o.y = cvtpk(bflo(kw[c].y) * r * g0[2], bfhi(kw[c].y) * r * g0[3]);
                o.z = cvtpk(bflo(kw[c].z) * r * g1[0], bfhi(kw[c].z) * r * g1[1]); o.w = cvtpk(bflo(kw[c].w) * r * g1[2], bfhi(kw[c].w) * r * g1[3]);
                *(LAS v4u*)(Kn + j * 72 + hf * 32 + 8 * c) = o; }
#pragma unroll
            for (int c = 0; c < 2; ++c) { LAS unsigned* vs = (LAS unsigned*)(vT + (qd * 16 + 8 * c) * 264 + 2 * jp); const v4u w0 = va[c], w1 = vb[c];
                vs[0 * 132] = (w0.x & 0xffff) | (w1.x << 16); vs[1 * 132] = (w0.x >> 16) | (w1.x & 0xffff0000u); vs[2 * 132] = (w0.y & 0xffff) | (w1.y << 16); vs[3 * 132] = (w0.y >> 16) | (w1.y & 0xffff0000u);
                vs[4 * 132] = (w0.z & 0xffff) | (w1.z << 16); vs[5 * 132] = (w0.z >> 16) | (w1.z & 0xffff0000u); vs[6 * 132] = (w0.w & 0xffff) | (w1.w << 16); vs[7 * 132] = (w0.w >> 16) | (w1.w & 0xffff0000u); }
        }
#ifdef PROBE_SWA_STAGE
        }
#endif
        LDSBAR();
        const f32x4 qg00 = *(const f32x4*)(qn + 8 * fq0), qg01 = *(const f32x4*)(qn + 8 * fq0 + 4), qg10 = *(const f32x4*)(qn + 32 + 8 * fq0), qg11 = *(const f32x4*)(qn + 32 + 8 * fq0 + 4);
        const f32x4 snk4 = *(const f32x4*)(sinks + kvh * 4);
        bf16x8 Kf[9][2];
#pragma unroll
        for (int sb = 0; sb < 9; ++sb)
#pragma unroll
            for (int ks = 0; ks < 2; ++ks) Kf[sb][ks] = *(const LAS bf16x8*)(Kn + (16 * (w + sb) + fr0) * 72 + 32 * ks + 8 * fq0);
#ifdef PROBE_SWA_HEADS
#pragma unroll 1
        for (int g8 = 0; g8 < 8; ++g8) { const int g = g8 & 3; if (g8 == 4) { const size_t tq = (size_t)b * SEQ + nbk * 128 + 16 * w + fr0; qn0 = *(const v4u*)(Z + tq * ZLD + ZSQ + kvh * 256 + 8 * fq0); qn1 = *(const v4u*)(Z + tq * ZLD + ZSQ + kvh * 256 + 32 + 8 * fq0); }
#else
#pragma unroll 2
        for (int g = 0; g < 4; ++g) {
#endif
            int fr = fr0, fq = fq0; asm volatile("" : "+v"(fr), "+v"(fq));
            const int qh = kvh * 4 + g; const size_t tok = (size_t)b * SEQ + nbk * 128 + 16 * w + fr;
            bf16x8 Yq[2];
            {   const v4u q0 = qn0, q1 = qn1;
                if (g < 3) { qn0 = *(const v4u*)(Z + tok * ZLD + ZSQ + (qh + 1) * 64 + 8 * fq); qn1 = *(const v4u*)(Z + tok * ZLD + ZSQ + (qh + 1) * 64 + 32 + 8 * fq); }
                float qf[16] = {bflo(q0.x), bfhi(q0.x), bflo(q0.y), bfhi(q0.y), bflo(q0.z), bfhi(q0.z), bflo(q0.w), bfhi(q0.w), bflo(q1.x), bfhi(q1.x), bflo(q1.y), bfhi(q1.y), bflo(q1.z), bfhi(q1.z), bflo(q1.w), bfhi(q1.w)};
                float ss = 0.f;
#pragma unroll
                for (int c = 0; c < 16; ++c) ss += qf[c] * qf[c];
                ss += __shfl_xor(ss, 16); ss += __shfl_xor(ss, 32);
                const float r = rsqrtf(ss * (1.0f / 64.0f) + EPS) * (0.125f * LOG2E);
#pragma unroll
                for (int ks = 0; ks < 2; ++ks) { const f32x4 g0 = ks ? qg10 : qg00, g1 = ks ? qg11 : qg01; const float* qq = qf + 8 * ks;
                    Yq[ks] = mk8(cvtpk(qq[0] * r * g0[0], qq[1] * r * g0[1]), cvtpk(qq[2] * r * g0[2], qq[3] * r * g0[3]), cvtpk(qq[4] * r * g1[0], qq[5] * r * g1[1]), cvtpk(qq[6] * r * g1[2], qq[7] * r * g1[3])); }
            }
            f32x4 sc[9];
#pragma unroll
            for (int sb = 0; sb < 9; ++sb) { sc[sb] = (f32x4){0.f, 0.f, 0.f, 0.f};
#pragma unroll
                for (int ks = 0; ks < 2; ++ks) sc[sb] = mfma16(Kf[sb][ks], Yq[ks], sc[sb]); }
            const float slope2 = exp2f(-(float)(qh + 1)) * LOG2E, sink2 = (g == 0 ? snk4[0] : g == 1 ? snk4[1] : g == 2 ? snk4[2] : snk4[3]) * LOG2E;
            const float nb = -slope2 * (float)(128 + fr - 4 * fq);
            const int dq = fr - 4 * fq;
            float mx = sink2;
#pragma unroll
            for (int sb = 0; sb < 9; ++sb) { const bool blk = !(nbk == 0 && w + sb < 8);
#pragma unroll
                for (int e = 0; e < 4; ++e) { const bool ok = blk && (sb == 0 ? (e > dq) : (sb == 8 ? (e <= dq) : true));
                    const float v = ok ? sc[sb][e] + (nb + slope2 * (float)(16 * sb + e)) : -INFINITY; sc[sb][e] = v; mx = fmaxf(mx, v); } }
            mx = fmaxf(mx, __shfl_xor(mx, 16)); mx = fmaxf(mx, __shfl_xor(mx, 32));
            float ls = 0.f;
#pragma unroll
            for (int sb = 0; sb < 9; ++sb)
#pragma unroll
                for (int e = 0; e < 4; ++e) { const float p = __builtin_amdgcn_exp2f(sc[sb][e] - mx); sc[sb][e] = p; ls += p; }
            ls += __shfl_xor(ls, 16); ls += __shfl_xor(ls, 32);
            ls += __builtin_amdgcn_exp2f(sink2 - mx);
            f32x4 o[4];
#pragma unroll
            for (int db = 0; db < 4; ++db) o[db] = (f32x4){0.f, 0.f, 0.f, 0.f};
#pragma unroll
            for (int k2 = 0; k2 < 5; ++k2) {
                const bf16x8 P = (k2 < 4) ? mk8(cvtpk(sc[2 * k2][0], sc[2 * k2][1]), cvtpk(sc[2 * k2][2], sc[2 * k2][3]), cvtpk(sc[(2 * k2 + 1) % 9][0], sc[(2 * k2 + 1) % 9][1]), cvtpk(sc[(2 * k2 + 1) % 9][2], sc[(2 * k2 + 1) % 9][3]))
                                          : mk8(cvtpk(sc[8][0], sc[8][1]), cvtpk(sc[8][2], sc[8][3]), 0u, 0u);
#pragma unroll
                for (int db = 0; db < 4; ++db) { const LAS bf16* vp = vT + (32 * (db >> 1) + 8 * (fr >> 2) + 4 * (db & 1) + (fr & 3)) * 264 + 16 * (w + 2 * k2) + 4 * fq;
                    const v2u lo = *(const LAS v2u*)vp, hi = (k2 < 4) ? *(const LAS v2u*)(vp + 16) : lo;
                    o[db] = mfma16(mk8(lo.x, lo.y, hi.x, hi.y), P, o[db]); }
            }
            const float inv = 1.0f / ls;
#pragma unroll
            for (int kk = 0; kk < 2; ++kk) { v4u wv; wv.x = cvtpk(o[2 * kk][0] * inv, o[2 * kk][1] * inv); wv.y = cvtpk(o[2 * kk][2] * inv, o[2 * kk][3] * inv); wv.z = cvtpk(o[2 * kk + 1][0] * inv, o[2 * kk + 1][1] * inv); wv.w = cvtpk(o[2 * kk + 1][2] * inv, o[2 * kk + 1][3] * inv);
                *(v4u*)(OMIX + tok * D + 512 + qh * 64 + 32 * kk + 8 * fq) = wv; }
        }
        LDSBAR();
    }
}

__device__ __forceinline__ void fixup_units(const pg8::StaticOrder& S) {
    unsigned char* const wsx = arg_ws();
    const float* HP = (const float*)(wsx + WS_HP); const float* HC = (const float*)(wsx + WS_HC); bf16* ACT = (bf16*)(wsx + WS_ACT);
    int tid_ = threadIdx.x; asm volatile("" : "+v"(tid_));
    pg8::Unit u;
    for (int i = 0; S.next(i, u); ++i) {
        const int pm = u.pm;
        if ((pm & 31) == 0) continue;
        for (int idx = tid_; idx < 2 * FF; idx += 512) {
            const int j = idx % FF, r = idx / FF;
            const int pn = j >> 7, jj = j & 127, ia = 256 * pn + jj, ib = ia + 128;
            const float* hp = HP + ((size_t)pm * 2 + r) * FF2; const float* hc = HC + ((size_t)(pm - 1) * 2 + (1 - r)) * FF2;
            const float ua = hp[ia] + hc[ia], ub = hp[ib] + hc[ib];
            ACT[(((size_t)pm * (FF / 64) + (j >> 6)) * 256 + r) * 64 + (j & 63)] = (bf16)f2bf(silu_f(ua) * ub);
        }
    }
    asm volatile("s_waitcnt vmcnt(0)" ::: "memory");
    __syncthreads();
}

#define XB_TMO      128
#define XB_XCNT(j)  (256  + 64 * (j))
#define XB_XSUB(j)  (1280 + 64 * (j))
#define XB_XGEN(j)  (2304 + 64 * (j))
#define XB_TOP      3328
#define XB_TOPGEN   3392
#define XCD_BAR_WORDS 3456
#define XB_SPIN_CAP (1u << 18)

__device__ __forceinline__ unsigned xb_ld(unsigned* p)              { return __hip_atomic_load(p, __ATOMIC_RELAXED, __HIP_MEMORY_SCOPE_AGENT); }
__device__ __forceinline__ unsigned xb_add(unsigned* p, unsigned v) { return __hip_atomic_fetch_add(p, v, __ATOMIC_RELAXED, __HIP_MEMORY_SCOPE_AGENT); }
__device__ __forceinline__ unsigned xb_xcc_id() { return (unsigned)__builtin_amdgcn_s_getreg((3 << 11) | 20) & 0xFu; }
#define XB_SPIN(cond, bar) do { unsigned _sp = 0; while (cond) { __builtin_amdgcn_s_sleep(1); \
    if ((++_sp & 255u) == 0u) { if (xb_ld(&(bar)[XB_TMO])) break; if (_sp > XB_SPIN_CAP) { atomicAdd(&(bar)[XB_TMO], 1u); break; } } } } while (0)

struct XcdBarrier {
    unsigned* bar; unsigned x;
    volatile LAS unsigned* st;
};

__device__ __forceinline__ XcdBarrier xcd_barrier_post(unsigned* bar, volatile LAS unsigned* st) {
    XcdBarrier b; b.bar = bar; b.x = xb_xcc_id(); b.st = st;
    if (threadIdx.x == 0) (void)xb_add(&bar[XB_XCNT(b.x)], 1u);
    return b;
}
__device__ __forceinline__ void xcd_barrier_complete(unsigned* bar, unsigned x, unsigned& nloc, unsigned& nx) {
    const unsigned G = gridDim.x * gridDim.y * gridDim.z;
    unsigned sum, cnt, mine, sp = 0u;
    for (;;) {
        sum = 0u; cnt = 0u; mine = 0u;
#pragma unroll
        for (unsigned j = 0; j < 16; ++j) { const unsigned c = xb_ld(&bar[XB_XCNT(j)]); sum += c; cnt += (c > 0u) ? 1u : 0u; mine = (j == x) ? c : mine; }
        if (sum == G) break;
        __builtin_amdgcn_s_sleep(1);
        if ((++sp & 255u) == 0u) { if (xb_ld(&bar[XB_TMO])) break; if (sp > XB_SPIN_CAP) { atomicAdd(&bar[XB_TMO], 1u); break; } }
    }
    nloc = mine > 0u ? mine : 1u; nx = cnt > 0u ? cnt : 1u;
}

__device__ __forceinline__ void xcd_barrier(const XcdBarrier& b) {
    asm volatile("s_waitcnt vmcnt(0)" ::: "memory");
    __syncthreads();
    if (threadIdx.x == 0) {
        unsigned* bar = b.bar;
        __builtin_amdgcn_s_waitcnt(0);
        unsigned nloc = b.st[0], nx = b.st[1];
        const unsigned old = xb_add(&bar[XB_XSUB(b.x)], 1u);
        const unsigned gen = old / nloc;
        if (old + 1u == (gen + 1u) * nloc) {
            __builtin_amdgcn_fence(__ATOMIC_RELEASE, "agent");
            asm volatile("s_waitcnt vmcnt(0)" ::: "memory");
            const unsigned og = xb_add(&bar[XB_TOP], 1u);
            const unsigned tg = og / nx;
            if (og + 1u == (tg + 1u) * nx) xb_add(&bar[XB_TOPGEN], 1u);
            else XB_SPIN(xb_ld(&bar[XB_TOPGEN]) == tg, bar);
            __builtin_amdgcn_fence(__ATOMIC_ACQUIRE, "agent");
            xb_add(&bar[XB_XGEN(b.x)], 1u);
            asm volatile("s_waitcnt vmcnt(0)" ::: "memory");
        } else {
            XB_SPIN(xb_ld(&bar[XB_XGEN(b.x)]) == gen, bar);
            __builtin_amdgcn_fence(__ATOMIC_ACQUIRE, "agent");
            asm volatile("s_waitcnt vmcnt(0)" ::: "memory");
        }
    }
    __syncthreads();
}

__device__ __forceinline__ void rstd_prefill(const pg8::StaticOrder& S, const float* ssq, LAS float* Rall) {
    int tid = threadIdx.x; asm volatile("" : "+v"(tid));
    pg8::Unit u;
    if (tid < 256) for (int i = 0; S.next(i, u); ++i) Rall[i * 256 + tid] = pg8::row_rstd16(ssq, u.pm * 256 + tid);
    __syncthreads();
}
#ifndef REP_G1
#define REP_G1 1
#endif
#ifndef REP_G6
#define REP_G6 1
#endif
#ifndef REP_P0
#define REP_P0 1
#endif
#ifndef REP_GA
#define REP_GA 1
#endif
#ifndef REP_SWA
#define REP_SWA 1
#endif
#ifndef REP_GB
#define REP_GB 1
#endif
#ifndef REP_GC
#define REP_GC 1
#endif
#ifndef REP_FIX
#define REP_FIX 1
#endif
__global__ void __launch_bounds__(512, 2) hymba_fwd(Args a) {
    extern __shared__ __attribute__((aligned(16))) unsigned char lds_raw[];
    LAS unsigned char* lds = (LAS unsigned char*)lds_raw;
    cg::grid_group grid = cg::this_grid();
    const int G = gridDim.x;
    unsigned char* ws = arg_ws();
    volatile LAS unsigned* bst = (volatile LAS unsigned*)(lds + XOFF + 8192 + 1024);
    if (threadIdx.x < 2) bst[threadIdx.x] = 0u;
    __syncthreads();
    const XcdBarrier bar = xcd_barrier_post((unsigned*)(ws + WS_CTL), bst);
#define GSYNC() do { XcdBarrier b2_ = bar; asm volatile("" : "+s"(b2_.x)); xcd_barrier(b2_); } while (0)
#ifndef SK_P0
    for (int rep = 0; rep < REP_P0; ++rep) p0_prologue(a, lds, G);
#endif
    if (threadIdx.x == 0) { unsigned nloc, nx; xcd_barrier_complete(bar.bar, bar.x, nloc, nx); bst[0] = nloc; bst[1] = nx; }
    __syncthreads();
    if (G == 0x7fffffff) grid.sync();
    GSYNC();
    for (int l = 0; l < DEPTH; ++l) {
#ifndef SK_G1
        {
            unsigned char* const ws = arg_ws();
            pg8::Gemm g{(const pg8::bf16_t*)(ws + WS_XB), (const pg8::bf16_t*)(ws + WS_WIN) + (size_t)l * N_IN * D, T, N_IN, D};
            pg8::StaticOrder S; S.init(T, N_IN, G, (int)blockIdx.x);
            rstd_prefill(S, (const float*)(ws + WS_SSQ), (LAS float*)(lds + RALL_OFF));
            pg8::EpiIn E{(pg8::bf16_t*)(ws + WS_Z), (float*)(ws + WS_LA), (const float*)(ws + WS_SSQ), arg_in(4) + l * 256, (LAS float*)(lds + RALL_OFF), 0};
#ifdef PROBE_G1_NOSTORE
            { pg8::EpiIn E2 = E; E2.nostore = (G > 0); pg8::gemm_phase<pg8::EpiIn, pg8::StaticOrder, true, true, D>(lds, g, S, E2); }
#endif
            for (int rep = 0; rep < REP_G1; ++rep) pg8::gemm_phase<pg8::EpiIn, pg8::StaticOrder, true, true, D>(lds, g, S, E);
        }
#endif
        GSYNC();
#ifndef SK_GA
        for (int rep = 0; rep < REP_GA; ++rep) gla_a_phase(a, lds, G);
#endif
#ifndef SK_SWA
        for (int rep = 0; rep < REP_SWA; ++rep) swa_phase(a, l, lds, G);
#endif
        GSYNC();
#ifndef SK_GB
        for (int rep = 0; rep < REP_GB; ++rep) gla_scan_phase(a, G);
#endif
        GSYNC();
#ifndef SK_GC
        for (int rep = 0; rep < REP_GC; ++rep) gla_c_phase(a, l, lds, G);
#endif
        GSYNC();
#ifndef SK_G5
        {
            unsigned char* const ws = arg_ws();
            pg8::Gemm g{(const pg8::bf16_t*)(ws + WS_OMIX), (const pg8::bf16_t*)(ws + WS_WOUT) + (size_t)l * D * D, T, D, D};
            pg8::StaticOrder S; S.init(T, D, G, (int)blockIdx.x);
#ifdef REP_G5X
            { pg8::EpiRes<true> EX{(pg8::bf16_t*)(ws + WS_XB), arg_out(), nullptr}; pg8::gemm_phase<pg8::EpiRes<true>, pg8::StaticOrder, true, true, D>(lds, g, S, EX); }
#endif
            pg8::EpiRes<false> E{(pg8::bf16_t*)(ws + WS_XB), nullptr, (float*)(ws + WS_SSQ)};
            pg8::gemm_phase<pg8::EpiRes<false>, pg8::StaticOrder, true, true, D>(lds, g, S, E);
        }
#endif
        GSYNC();
#ifndef SK_G6
        {
            unsigned char* const ws = arg_ws();
            pg8::Gemm g{(const pg8::bf16_t*)(ws + WS_XB), (const pg8::bf16_t*)(ws + WS_WUP) + (size_t)l * FF2 * D, T, FF2, D};
            pg8::StaticOrder S; S.init(T, FF2, G, (int)blockIdx.x);
            rstd_prefill(S, (const float*)(ws + WS_SSQ), (LAS float*)(lds + RALL_OFF));
            pg8::EpiUp E{(pg8::bf16_t*)(ws + WS_ACT), arg_in(12) + (size_t)l * 3 * FF2, arg_in(13) + (size_t)l * FF2, (float*)(ws + WS_HP), (float*)(ws + WS_HC), (LAS float*)(lds + XOFF), (LAS float*)(lds + RALL_OFF), (LAS float*)(lds + XOFF + 8192 + 2048), {0.f, 0.f}};
            for (int rep = 0; rep < REP_G6; ++rep) pg8::gemm_phase<pg8::EpiUp, pg8::StaticOrder, true, true, D>(lds, g, S, E);
        }
#endif
        GSYNC();
#ifndef SK_G7
        {
            unsigned char* const ws = arg_ws();
            pg8::Gemm g{(const pg8::bf16_t*)(ws + WS_ACT), (const pg8::bf16_t*)(ws + WS_WDN) + (size_t)l * D * FF, T, D, FF};
            pg8::StaticOrder S; S.init(T, D, G, (int)blockIdx.x);
            fixup_units(S);
#ifdef REP_G7X
            { pg8::EpiRes<true> EX{(pg8::bf16_t*)(ws + WS_XB), arg_out(), nullptr}; pg8::gemm_phase<pg8::EpiRes<true>, pg8::StaticOrder, true, true, FF, true>(lds, g, S, EX); }
#endif
            if (l + 1 < DEPTH) { pg8::EpiRes<false> E{(pg8::bf16_t*)(ws + WS_XB), nullptr, (float*)(ws + WS_SSQ)};
                pg8::gemm_phase<pg8::EpiRes<false>, pg8::StaticOrder, true, true, FF, true>(lds, g, S, E); }
            else { pg8::EpiRes<true> E{(pg8::bf16_t*)(ws + WS_XB), arg_out(), nullptr};
                pg8::gemm_phase<pg8::EpiRes<true>, pg8::StaticOrder, true, true, FF, true>(lds, g, S, E); }
        }
#endif
#ifdef PROBE_SYNC
        GSYNC(); GSYNC(); GSYNC(); GSYNC();
#endif
        if (l + 1 < DEPTH) GSYNC();
    }
}

extern "C" void kernel_launch(void* const* d_in, const int* in_sizes, int n_in, void* d_out, int out_size, void* d_ws, size_t ws_size, hipStream_t stream) {
    static int grid = 0;
    if (grid == 0) {
        if (n_in != 15 || out_size != T * D || ws_size < WS_END) { fprintf(stderr, "kernel_launch: unexpected shapes (n_in %d out %d ws %zu)\n", n_in, out_size, ws_size); grid = -1; return; }
        int dev = 0, cus = 0, per_cu = 0;
        hipGetDevice(&dev); hipDeviceGetAttribute(&cus, hipDeviceAttributeMultiprocessorCount, dev);
        hipFuncSetAttribute((const void*)hymba_fwd, hipFuncAttributeMaxDynamicSharedMemorySize, LDS_BYTES);
        hipOccupancyMaxActiveBlocksPerMultiprocessor(&per_cu, (const void*)hymba_fwd, 512, LDS_BYTES);
        if (per_cu < 1) per_cu = 1;
        grid = cus * per_cu;
        (void)hipGetLastError();
    }
    if (grid < 0) return;
    if (hipMemsetAsync((char*)d_ws + WS_CTL, 0, CTL_ZERO_BYTES, stream) != hipSuccess) { fprintf(stderr, "memset failed\n"); return; }
    Args a{};
    for (int i = 0; i < 15; ++i) a.in[i] = (const float*)d_in[i];
    a.out = (float*)d_out; a.ws = (unsigned char*)d_ws;
    void* args[] = {&a};
    hipError_t e = hipLaunchCooperativeKernel((const void*)hymba_fwd, dim3(grid), dim3(512), args, LDS_BYTES, stream);
    if (e != hipSuccess) fprintf(stderr, "cooperative launch failed: %s (grid %d)\n", hipGetErrorString(e), grid);
}
```

```cpp
#include <hip/hip_runtime.h>
#include <hip/hip_cooperative_groups.h>
#include <cstdio>
#include <cstdint>
namespace cg = cooperative_groups;
namespace pg8 {
#define PG8_LAS __attribute__((address_space(3)))
typedef unsigned short bf16_t;
typedef short bf16x8 __attribute__((ext_vector_type(8)));
typedef float f32x4 __attribute__((ext_vector_type(4)));
typedef unsigned u32x4 __attribute__((ext_vector_type(4)));
constexpr int BM = 256, BK = 64, HALF = 128, HTB = HALF * BK * 2  , STAGE_BYTES = 8 * HTB, NXCD = 8, WGM = 8;

__host__ __device__ __forceinline__ int lds_byte(int r, int c) { const int st = (r >> 4) * 2 + (c >> 5), rr = r & 15, cc = c & 31, ob = rr * 64 + cc * 2; return st * 1024 + (ob ^ (((ob >> 9) & 1) << 5)); }
__host__ __device__ __forceinline__ void stage_rc(int b, int& R, int& C) { const int st = b / 1024, sb = b % 1024, swz = sb ^ (((sb >> 9) & 1) << 5); R = (st >> 1) * 16 + swz / 64; C = (st & 1) * 32 + (swz % 64) / 2; }
__host__ __device__ __forceinline__ int perm32(int rho) { const int n = rho >> 4, i = rho & 15; return 8 * (i >> 2) + 4 * n + (i & 3); }

struct Unit { int pm, pn, ui; };
struct Gemm { const bf16_t* A; const bf16_t* Bt; int M, N, K; };

struct StaticOrder {
    int nM, nN, nwg, G, c;
    __host__ __device__ void init(int M, int N, int G_, int c_) { nM = M / BM; nN = N / BM; nwg = nM * nN; G = G_; c = c_; }
    __host__ __device__ bool next(int i, Unit& u) const {
        const long L = (long)i * G + c; if (L >= nwg) return false;
        int wgid = (int)L; { const int q = nwg / NXCD, r = nwg % NXCD, xcd = wgid % NXCD, off = wgid / NXCD; wgid = (xcd < r ? xcd * (q + 1) : r * (q + 1) + (xcd - r) * q) + off; }
        const int nig = WGM * nN, gid = wgid / nig, fm = gid * WGM, gsz = (nM - fm) < WGM ? (nM - fm) : WGM;
        u.pm = fm + ((wgid % nig) % gsz); u.pn = (wgid % nig) / gsz; u.ui = i; return true;
    }
    __device__ __forceinline__ void a_ready(const Unit&) const {}
    __device__ __forceinline__ void done(const Unit&) const {}
};
struct PairOrder {
    StaticOrder so; bool pair; int pm, pn0;
    __host__ __device__ void init(int M, int N, int G_, int c_) { so.init(M, N, G_, c_); pair = (G_ == 256 && so.nM == 128 && so.nN == 4);
        const int xcd = c_ & 7, j = c_ >> 3; pm = xcd * 16 + (j & 15); pn0 = (j >> 4) * 2; }
    __host__ __device__ bool next(int i, Unit& u) const { if (!pair) return so.next(i, u); if (i >= 2) return false; u.pm = pm; u.pn = pn0 + i; u.ui = i; return true; }
    __device__ __forceinline__ void a_ready(const Unit&) const {}
    __device__ __forceinline__ void done(const Unit&) const {}
};


__device__ __forceinline__ unsigned cvt_pk_bf16(float lo, float hi) { unsigned r; asm volatile("v_cvt_pk_bf16_f32 %0, %1, %2" : "=v"(r) : "v"(lo), "v"(hi)); return r; }
typedef float f32x2 __attribute__((ext_vector_type(2)));
constexpr float RMS_EPS = 1e-6f;
constexpr int ZLD = 2304, FF2 = 5632, FF = 2816, DM = 1024;
__device__ __forceinline__ float row_rstd16(const float* ssq, int row) {
    const f32x4* p = (const f32x4*)(ssq + (size_t)row * 16);
    const f32x4 a = p[0], b = p[1], c = p[2], d = p[3];
    const float s = (((a[0] + a[1]) + (a[2] + a[3])) + ((b[0] + b[1]) + (b[2] + b[3]))) + (((c[0] + c[1]) + (c[2] + c[3])) + ((d[0] + d[1]) + (d[2] + d[3])));
    return rsqrtf(s * (1.0f / 1024.0f) + RMS_EPS);
}
__device__ __forceinline__ void rstd_to_lds(const float* ssq, int row_base, PG8_LAS float* R, int wr, int wc, int fr, int fq) {
    const int tid = (wr * 4 + wc) * 64 + fq * 16 + fr;
    if (tid < 256) R[tid] = row_rstd16(ssq, row_base + tid);
    asm volatile("s_waitcnt lgkmcnt(0)" ::: "memory"); __builtin_amdgcn_s_barrier(); asm volatile("" ::: "memory");
}
__device__ __forceinline__ float silu_f(float x) { return x * __builtin_amdgcn_rcpf(1.0f + __expf(-x)); }
__device__ __forceinline__ float logsig_f(float x) { return fminf(x, 0.0f) - __logf(1.0f + __expf(-fabsf(x))); }

struct EpiIn {
    static constexpr bool PERM = true, AFTER_DRAIN = false;
    bf16_t* Z; float* LA; const float* ssq; const float* b_alpha; PG8_LAS float* R; int nostore;
    __device__ __forceinline__ void prefetch(const Unit&, int) {}
    __device__ __forceinline__ void operator()(const f32x4 (&acc)[2][2][4][2], const Unit& u, int wr, int wc, int fr_, int fq_) const {
        int fr = fr_, fq = fq_; asm volatile("" : "+v"(fr), "+v"(fq));
        const int row0 = u.pm * BM + wr * 64 + fr, pn = u.pn, colw = wc * 32 + 8 * fq;
#pragma unroll
        for (int ai = 0; ai < 2; ++ai)
#pragma unroll
            for (int m = 0; m < 4; ++m) {
                const int row = row0 + ai * HALF + m * 16; const float rs = R[u.ui * BM + ai * HALF + wr * 64 + m * 16 + fr];
#pragma unroll
                for (int bj = 0; bj < 2; ++bj) {
                    f32x4 v0 = acc[ai][bj][m][0] * rs, v1 = acc[ai][bj][m][1] * rs; const int c = bj * HALF + colw;
                    if (pn == 9) {
                        const f32x4 b0 = *(const f32x4*)(b_alpha + c), b1 = *(const f32x4*)(b_alpha + c + 4);
#pragma unroll
                        for (int e = 0; e < 4; ++e) { v0[e] = logsig_f(v0[e] + b0[e]) * 0.0625f; v1[e] = logsig_f(v1[e] + b1[e]) * 0.0625f; }
                        u32x4 w; w.x = cvt_pk_bf16(v0[0], v0[1]); w.y = cvt_pk_bf16(v0[2], v0[3]); w.z = cvt_pk_bf16(v1[0], v1[1]); w.w = cvt_pk_bf16(v1[2], v1[3]);
                        if (!nostore) *(u32x4*)((bf16_t*)LA + (size_t)row * 256 + c) = w;
                    } else {
                        if (pn == 0) { v0 = v0 * 0.125f; v1 = v1 * 0.125f; }
                        else if (pn == 4 || pn == 5) {
#pragma unroll
                            for (int e = 0; e < 4; ++e) { v0[e] = silu_f(v0[e]); v1[e] = silu_f(v1[e]); } }
                        u32x4 w; w.x = cvt_pk_bf16(v0[0], v0[1]); w.y = cvt_pk_bf16(v0[2], v0[3]); w.z = cvt_pk_bf16(v1[0], v1[1]); w.w = cvt_pk_bf16(v1[2], v1[3]);
                        if (!nostore) *(u32x4*)(Z + (size_t)row * ZLD + pn * BM + c) = w;
                    }
                }
            }
    }
};

template <bool FINAL> struct EpiRes {
    static constexpr bool PERM = true, AFTER_DRAIN = false;
    bf16_t* XB; float* xout; float* ssq;
    u32x4 pre[2][2];
    __device__ __forceinline__ void prefetch(const Unit& u, int tid) {
        const int wid = tid >> 6, lane = tid & 63, wr = wid >> 2, wc = wid & 3, fr = lane & 15, fq = lane >> 4;
        const int row0 = u.pm * BM + wr * 64 + fr, col0 = u.pn * BM + wc * 32 + 8 * fq;
#pragma unroll
        for (int m = 0; m < 2; ++m)
#pragma unroll
            for (int bj = 0; bj < 2; ++bj) pre[m][bj] = *(const u32x4*)(XB + (size_t)(row0 + m * 16) * DM + col0 + bj * HALF);
    }
    __device__ __forceinline__ void operator()(const f32x4 (&acc)[2][2][4][2], const Unit& u, int wr, int wc, int fr_, int fq_) const {
        int fr = fr_, fq = fq_; asm volatile("" : "+v"(fr), "+v"(fq));
        const int row0 = u.pm * BM + wr * 64 + fr, col0 = u.pn * BM + wc * 32 + 8 * fq;
#pragma unroll
        for (int ai = 0; ai < 2; ++ai)
#pragma unroll
            for (int m = 0; m < 4; ++m) {
                const int row = row0 + ai * HALF + m * 16; float s = 0.f;
#pragma unroll
                for (int bj = 0; bj < 2; ++bj) {
                    const size_t off = (size_t)row * DM + col0 + bj * HALF;
                    const u32x4 r = (ai == 0 && m < 2) ? pre[m][bj] : *(const u32x4*)(XB + off);
                    f32x4 v0 = acc[ai][bj][m][0], v1 = acc[ai][bj][m][1];
                    v0[0] += __builtin_bit_cast(float, r.x << 16); v0[1] += __builtin_bit_cast(float, r.x & 0xffff0000u); v0[2] += __builtin_bit_cast(float, r.y << 16); v0[3] += __builtin_bit_cast(float, r.y & 0xffff0000u);
                    v1[0] += __builtin_bit_cast(float, r.z << 16); v1[1] += __builtin_bit_cast(float, r.z & 0xffff0000u); v1[2] += __builtin_bit_cast(float, r.w << 16); v1[3] += __builtin_bit_cast(float, r.w & 0xffff0000u);
                    if (FINAL) { *(f32x4*)(xout + off) = v0; *(f32x4*)(xout + off + 4) = v1; }
                    else {
                        u32x4 w; w.x = cvt_pk_bf16(v0[0], v0[1]); w.y = cvt_pk_bf16(v0[2], v0[3]); w.z = cvt_pk_bf16(v1[0], v1[1]); w.w = cvt_pk_bf16(v1[2], v1[3]);
                        *(u32x4*)(XB + off) = w;
                        s += ((v0[0] * v0[0] + v0[1] * v0[1]) + (v0[2] * v0[2] + v0[3] * v0[3])) + ((v1[0] * v1[0] + v1[1] * v1[1]) + (v1[2] * v1[2] + v1[3] * v1[3]));
                    }
                }
                if (!FINAL) { s += __shfl_xor(s, 16); s += __shfl_xor(s, 32);
                    if (fq == 0) ssq[(size_t)row * 16 + u.pn * 4 + wc] = s; }
            }
    }
};

template <int CTRL> __device__ __forceinline__ float dppz(float v) { return __builtin_bit_cast(float, __builtin_amdgcn_update_dpp(0, __builtin_bit_cast(int, v), CTRL, 0xf, 0xf, true)); }
template <int CTRL> __device__ __forceinline__ f32x4 dppz4(f32x4 v) { f32x4 r; r[0] = dppz<CTRL>(v[0]); r[1] = dppz<CTRL>(v[1]); r[2] = dppz<CTRL>(v[2]); r[3] = dppz<CTRL>(v[3]); return r; }
__device__ __forceinline__ void conv_taps(f32x4& uo, const f32x4& x, const f32x4& xp, const f32x4& w0, const f32x4& w1) {
    float u0 = uo[0], u1 = uo[1], u2 = uo[2], u3 = uo[3];
    asm volatile("s_nop 1\n\t"
        "v_fmac_f32_dpp %0, %4, %16 row_shr:1 row_mask:0xf bank_mask:0xf bound_ctrl:0\n\t"
        "v_fmac_f32_dpp %1, %5, %17 row_shr:1 row_mask:0xf bank_mask:0xf bound_ctrl:0\n\t"
        "v_fmac_f32_dpp %2, %6, %18 row_shr:1 row_mask:0xf bank_mask:0xf bound_ctrl:0\n\t"
        "v_fmac_f32_dpp %3, %7, %19 row_shr:1 row_mask:0xf bank_mask:0xf bound_ctrl:0\n\t"
        "v_fmac_f32_dpp %0, %4, %12 row_shr:2 row_mask:0xf bank_mask:0xf bound_ctrl:0\n\t"
        "v_fmac_f32_dpp %1, %5, %13 row_shr:2 row_mask:0xf bank_mask:0xf bound_ctrl:0\n\t"
        "v_fmac_f32_dpp %2, %6, %14 row_shr:2 row_mask:0xf bank_mask:0xf bound_ctrl:0\n\t"
        "v_fmac_f32_dpp %3, %7, %15 row_shr:2 row_mask:0xf bank_mask:0xf bound_ctrl:0\n\t"
        "v_fmac_f32_dpp %0, %8, %16 row_shl:15 row_mask:0xf bank_mask:0xf bound_ctrl:0\n\t"
        "v_fmac_f32_dpp %1, %9, %17 row_shl:15 row_mask:0xf bank_mask:0xf bound_ctrl:0\n\t"
        "v_fmac_f32_dpp %2, %10, %18 row_shl:15 row_mask:0xf bank_mask:0xf bound_ctrl:0\n\t"
        "v_fmac_f32_dpp %3, %11, %19 row_shl:15 row_mask:0xf bank_mask:0xf bound_ctrl:0\n\t"
        "v_fmac_f32_dpp %0, %8, %12 row_shl:14 row_mask:0xf bank_mask:0xf bound_ctrl:0\n\t"
        "v_fmac_f32_dpp %1, %9, %13 row_shl:14 row_mask:0xf bank_mask:0xf bound_ctrl:0\n\t"
        "v_fmac_f32_dpp %2, %10, %14 row_shl:14 row_mask:0xf bank_mask:0xf bound_ctrl:0\n\t"
        "v_fmac_f32_dpp %3, %11, %15 row_shl:14 row_mask:0xf bank_mask:0xf bound_ctrl:0"
        : "+v"(u0), "+v"(u1), "+v"(u2), "+v"(u3)
        : "v"(x[0]), "v"(x[1]), "v"(x[2]), "v"(x[3]), "v"(xp[0]), "v"(xp[1]), "v"(xp[2]), "v"(xp[3]),
          "v"(w0[0]), "v"(w0[1]), "v"(w0[2]), "v"(w0[3]), "v"(w1[0]), "v"(w1[1]), "v"(w1[2]), "v"(w1[3]));
    uo[0] = u0; uo[1] = u1; uo[2] = u2; uo[3] = u3;
}
struct EpiUp {
    static constexpr bool PERM = true, AFTER_DRAIN = false;
    bf16_t* ACT; const float* cw; const float* cb; float* HP; float* HC; PG8_LAS float* X; PG8_LAS float* R; PG8_LAS float* W;
    typedef float f32x2w __attribute__((ext_vector_type(2)));
    f32x2w pf;
    __device__ __forceinline__ void prefetch(const Unit& u, int tid) {
        const int t2 = tid * 2, k = t2 >> 8, gc = t2 & 255, oc = (gc >> 7) * FF + HALF * u.pn + (gc & 127);
        pf = *(const f32x2w*)((k < 3) ? cw + k * FF2 + oc : cb + oc);
    }
    __device__ __forceinline__ void operator()(const f32x4 (&acc)[2][2][4][2], const Unit& u, int wr, int wc, int fr_, int fq_) const {
        int fr = fr_, fq = fq_; asm volatile("" : "+v"(fr), "+v"(fq));
        *(PG8_LAS f32x2w*)(W + ((wr * 4 + wc) * 64 + fq * 16 + fr) * 2) = pf;
        const PG8_LAS float* Ru = R + u.ui * BM;
        const int rl0 = wr * 64 + fr;
        const int cint = wc * 32 + 8 * fq, oc0 = HALF * u.pn + cint, gc0 = BM * u.pn + cint;
        if (fr >= 14) {
#pragma unroll
            for (int ai = 0; ai < 2; ++ai) { const int q = 2 * ai + wr; const float rs3 = Ru[ai * HALF + rl0 + 48];
#pragma unroll
                for (int bj = 0; bj < 2; ++bj)
#pragma unroll
                    for (int n = 0; n < 2; ++n) *(PG8_LAS f32x4*)(X + ((q * 4 + wc) * 2 + (fr - 14)) * 64 + (bj * 2 + n) * 16 + fq * 4) = acc[ai][bj][3][n] * rs3; }
        }
        asm volatile("s_waitcnt lgkmcnt(0)" ::: "memory"); __builtin_amdgcn_s_barrier(); asm volatile("" ::: "memory");
#pragma unroll
        for (int ai = 0; ai < 2; ++ai) { const int q = 2 * ai + wr;
            float rs[4];
#pragma unroll
            for (int m = 0; m < 4; ++m) rs[m] = Ru[ai * HALF + rl0 + 16 * m];
#pragma unroll
            for (int n = 0; n < 2; ++n) {
                f32x4 ua[4];
#pragma unroll
                for (int bj = 0; bj < 2; ++bj) {
                    __builtin_amdgcn_sched_barrier(0);
                    const int lc = bj * HALF + cint + 4 * n;
                    const f32x4 w0 = *(const PG8_LAS f32x4*)(W + lc), w1 = *(const PG8_LAS f32x4*)(W + 256 + lc), w2 = *(const PG8_LAS f32x4*)(W + 512 + lc), bb = *(const PG8_LAS f32x4*)(W + 768 + lc);
                    f32x4 xp = (f32x4){0.f, 0.f, 0.f, 0.f};
                    if (q != 0) xp = *(const PG8_LAS f32x4*)(X + (((q - 1) * 4 + wc) * 2 + (fr & 1)) * 64 + (bj * 2 + n) * 16 + fq * 4);
#pragma unroll
                    for (int m = 0; m < 4; ++m) {
                        const f32x4 x = acc[ai][bj][m][n] * rs[m];
                        f32x4 uo = w2 * x + bb;
                        conv_taps(uo, x, xp, w0, w1);
                        xp = x;
                        if (m == 0) { if (q == 0 && fr < 2) *(f32x4*)(HP + ((size_t)u.pm * 2 + fr) * FF2 + gc0 + bj * HALF + 4 * n) = uo; }
                        if (m == 3) { if (q == 3) {
                            const f32x4 c1 = w1 * x + w0 * dppz4<0x111>(x);
                            if (fr == 15) { float* hp = HC + ((size_t)u.pm * 2) * FF2 + gc0 + bj * HALF + 4 * n; *(f32x4*)hp = w0 * x; *(f32x4*)(hp + FF2) = c1; } } }
                        if (bj == 0) ua[m] = uo;
                        else { const f32x4 a = ua[m];
                            typedef unsigned u32x2 __attribute__((ext_vector_type(2))); u32x2 w; w.x = cvt_pk_bf16(silu_f(a[0]) * uo[0], silu_f(a[1]) * uo[1]); w.y = cvt_pk_bf16(silu_f(a[2]) * uo[2], silu_f(a[3]) * uo[3]);
                            *(u32x2*)(ACT + (((size_t)u.pm * (FF / 64) + (oc0 >> 6)) * BM + ai * HALF + rl0 + 16 * m) * 64 + (oc0 & 63) + 4 * n) = w; }
                    }
                }
            }
        }
    }
};
template <class Epi, class Sched, bool ALIGN_EPI, bool SP2, int KC, bool ATILE = false>
__device__ __forceinline__ void gemm_phase(PG8_LAS unsigned char* lds, const Gemm g, const Sched& S, const Epi& E) {
    int tid_ = threadIdx.x; asm volatile("" : "+v"(tid_)); const int tid = tid_, wid = __builtin_amdgcn_readfirstlane(tid >> 6), lane = tid & 63, wr = wid >> 2, wc = wid & 3, fr = lane & 15, fq = lane >> 4;
    constexpr int K = KC, nt = K / BK;
    unsigned voffA[2], voffB[2];
#pragma unroll
    for (int i = 0; i < 2; ++i) { int R, C; stage_rc(tid * 16 + i * 8192, R, C); const int Rb = Epi::PERM ? ((R & ~31) + perm32(R & 31)) : R;
        voffA[i] = ATILE ? (unsigned)(R * BK + C) * 2u : (unsigned)(R * K + C) * 2u; voffB[i] = (unsigned)(Rb * K + C) * 2u; }
    const size_t kstep = (size_t)(BK * 2);
    const size_t hstep = (size_t)HALF * K * 2;
    const size_t tstep = 2 * hstep;
    const size_t kstepA = ATILE ? (size_t)(BM * BK * 2) : kstep, hstepA = ATILE ? (size_t)(HALF * BK * 2) : hstep, tstepA = ATILE ? (size_t)nt * (BM * BK * 2) : tstep;
    const unsigned ldsw = (unsigned)wid * 1024u;
    const int aoff = lds_byte(wr * 64 + fr, fq * 8), boff = lds_byte(wc * 32 + fr, fq * 8);
#define PG8_SA(b, h) (((b) * 2 + (h)) * HTB)
#define PG8_SB(b, h) ((4 + (b) * 2 + (h)) * HTB)
#define PG8_STAGE(bufoff, gbase, voff) do { _Pragma("unroll") for (int _i = 0; _i < 2; ++_i) \
        __builtin_amdgcn_global_load_lds((const unsigned*)((const char*)(gbase) + (voff)[_i]), (PG8_LAS unsigned*)(lds + (bufoff) + ldsw + _i * 8192), 16, 0, 0); } while (0)
#define PG8_LDA(dst, b, h) do { _Pragma("unroll") for (int m = 0; m < 4; ++m) _Pragma("unroll") for (int k = 0; k < 2; ++k) dst[m][k] = *(const PG8_LAS bf16x8*)(lds + PG8_SA(b, h) + aoff + m * 2048 + k * 1024); } while (0)
#define PG8_LDB(dst, b, h) do { _Pragma("unroll") for (int n = 0; n < 2; ++n) _Pragma("unroll") for (int k = 0; k < 2; ++k) dst[n][k] = *(const PG8_LAS bf16x8*)(lds + PG8_SB(b, h) + boff + n * 2048 + k * 1024); } while (0)
#define PG8_MMA(ai, bj, At, Bt) do { __builtin_amdgcn_s_setprio(1); _Pragma("unroll") for (int m = 0; m < 4; ++m) _Pragma("unroll") for (int n = 0; n < 2; ++n) _Pragma("unroll") for (int k = 0; k < 2; ++k) \
        acc[ai][bj][m][n] = __builtin_amdgcn_mfma_f32_16x16x32_bf16(Bt[n][k], At[m][k], acc[ai][bj][m][n], 0, 0, 0); __builtin_amdgcn_s_setprio(0); } while (0)
#define PG8_WAIT_V(n) asm volatile("s_waitcnt vmcnt(" #n ")" ::: "memory")
#define PG8_WAIT_L(n) asm volatile("s_waitcnt lgkmcnt(" #n ")" ::: "memory")
#define PG8_BAR __builtin_amdgcn_s_barrier()
#define PG8_SCHED __builtin_amdgcn_sched_barrier(0)
    Unit cur, nxt; int ui = 0; Epi EE = E;
    if (!S.next(0, cur)) return;
    f32x4 acc[2][2][4][2];
#pragma unroll
    for (int a = 0; a < 2; ++a)
#pragma unroll
        for (int b = 0; b < 2; ++b)
#pragma unroll
            for (int m = 0; m < 4; ++m)
#pragma unroll
                for (int n = 0; n < 2; ++n) acc[a][b][m][n] = (f32x4){0.f, 0.f, 0.f, 0.f};
    bf16x8 At[4][2], B0[2][2], B1[2][2];
    const char* cA = (const char*)g.A + (size_t)cur.pm * tstepA; const char* cB = (const char*)g.Bt + (size_t)cur.pn * tstep;
    S.a_ready(cur);
    if constexpr (SP2) {
        PG8_STAGE(PG8_SB(0, 0), cB, voffB); PG8_STAGE(PG8_SB(0, 1), cB + hstep, voffB); PG8_STAGE(PG8_SA(0, 0), cA, voffA); PG8_STAGE(PG8_SA(0, 1), cA + hstepA, voffA);
        if (wr == 1) PG8_BAR;
        PG8_WAIT_V(2); PG8_BAR;
        PG8_STAGE(PG8_SB(1, 0), cB + kstep, voffB); PG8_STAGE(PG8_SA(1, 0), cA + kstepA, voffA); PG8_STAGE(PG8_SB(1, 1), cB + hstep + kstep, voffB);
        PG8_WAIT_V(6); PG8_BAR;
    } else {
        PG8_STAGE(PG8_SB(0, 0), cB, voffB); PG8_STAGE(PG8_SA(0, 0), cA, voffA); PG8_STAGE(PG8_SB(0, 1), cB + hstep, voffB); PG8_STAGE(PG8_SA(0, 1), cA + hstepA, voffA);
        if (wr == 1) PG8_BAR;
        PG8_WAIT_V(4); PG8_BAR;
        PG8_STAGE(PG8_SB(1, 0), cB + kstep, voffB); PG8_STAGE(PG8_SA(1, 0), cA + kstepA, voffA); PG8_STAGE(PG8_SB(1, 1), cB + hstep + kstep, voffB);
        PG8_WAIT_V(6); PG8_BAR;
    }
    for (;;) {
        const bool has_next = S.next(ui + 1, nxt);
        const char* nA = has_next ? (const char*)g.A + (size_t)nxt.pm * tstepA : cA; const char* nB = has_next ? (const char*)g.Bt + (size_t)nxt.pn * tstep : cB;
        for (int t = 0; t < nt; t += 2) {
            const bool last = (t == nt - 2);
            const char* a1 = cA + (size_t)(t + 1) * kstepA;
            const char* a2 = last ? nA : cA + (size_t)(t + 2) * kstepA; const char* b2 = last ? nB : cB + (size_t)(t + 2) * kstep;
            const char* a3 = a2 + kstepA; const char* b3 = b2 + kstep;
            if (last && has_next) S.a_ready(nxt);
            if (last) EE.prefetch(cur, tid);
            if constexpr (SP2) {
            PG8_LDB(B0, 0, 0); PG8_LDB(B1, 0, 1); PG8_SCHED; PG8_LDA(At, 0, 0); PG8_STAGE(PG8_SA(1, 1), a1 + hstepA, voffA);
            PG8_WAIT_V(8); PG8_WAIT_L(0); PG8_BAR; PG8_MMA(0, 0, At, B0); PG8_MMA(0, 1, At, B1); PG8_BAR; PG8_SCHED;
            PG8_LDA(At, 0, 1); PG8_STAGE(PG8_SB(0, 0), b2, voffB); PG8_STAGE(PG8_SB(0, 1), b2 + hstep, voffB); PG8_STAGE(PG8_SA(0, 0), a2, voffA);
            PG8_WAIT_V(8); PG8_WAIT_L(0); PG8_BAR; PG8_MMA(1, 0, At, B0); PG8_MMA(1, 1, At, B1); PG8_BAR; PG8_SCHED;
            PG8_LDB(B0, 1, 0); PG8_LDB(B1, 1, 1); PG8_SCHED; PG8_LDA(At, 1, 0); PG8_STAGE(PG8_SA(0, 1), a2 + hstepA, voffA);
            PG8_WAIT_V(8); PG8_WAIT_L(0); PG8_BAR; PG8_MMA(0, 0, At, B0); PG8_MMA(0, 1, At, B1); PG8_BAR; PG8_SCHED;
            PG8_LDA(At, 1, 1); PG8_STAGE(PG8_SB(1, 0), b3, voffB); PG8_STAGE(PG8_SB(1, 1), b3 + hstep, voffB); PG8_STAGE(PG8_SA(1, 0), a3, voffA);
            PG8_WAIT_V(8); PG8_WAIT_L(0); PG8_BAR; PG8_MMA(1, 0, At, B0); PG8_MMA(1, 1, At, B1); PG8_BAR; PG8_SCHED;
            } else {
            PG8_LDB(B0, 0, 0); PG8_SCHED; PG8_LDA(At, 0, 0); PG8_STAGE(PG8_SA(1, 1), a1 + hstepA, voffA);
            PG8_WAIT_L(8); PG8_BAR; PG8_WAIT_L(0); PG8_MMA(0, 0, At, B0); PG8_BAR; PG8_SCHED;
            PG8_LDB(B1, 0, 1); PG8_STAGE(PG8_SB(0, 0), b2, voffB);
            PG8_BAR; PG8_WAIT_L(0); PG8_MMA(0, 1, At, B1); PG8_BAR;
            PG8_LDA(At, 0, 1); PG8_STAGE(PG8_SA(0, 0), a2, voffA);
            PG8_BAR; PG8_WAIT_L(0); PG8_MMA(1, 0, At, B0); PG8_BAR; PG8_SCHED;
            PG8_STAGE(PG8_SB(0, 1), b2 + hstep, voffB);
            PG8_WAIT_V(6); PG8_BAR; PG8_MMA(1, 1, At, B1); PG8_BAR;
            PG8_LDB(B0, 1, 0); PG8_SCHED; PG8_LDA(At, 1, 0); PG8_STAGE(PG8_SA(0, 1), a2 + hstepA, voffA);
            PG8_WAIT_L(8); PG8_BAR; PG8_WAIT_L(0); PG8_MMA(0, 0, At, B0); PG8_BAR; PG8_SCHED;
            PG8_LDB(B1, 1, 1); PG8_STAGE(PG8_SB(1, 0), b3, voffB);
            PG8_BAR; PG8_WAIT_L(0); PG8_MMA(0, 1, At, B1); PG8_BAR;
            PG8_LDA(At, 1, 1); PG8_STAGE(PG8_SA(1, 0), a3, voffA);
            PG8_BAR; PG8_WAIT_L(0); PG8_MMA(1, 0, At, B0); PG8_BAR; PG8_SCHED;
            PG8_STAGE(PG8_SB(1, 1), b3 + hstep, voffB);
            PG8_WAIT_V(6); PG8_BAR; PG8_MMA(1, 1, At, B1); PG8_BAR;
            }
        }
        if constexpr (ALIGN_EPI) { if (wr == 0) PG8_BAR; }
        if constexpr (!Epi::AFTER_DRAIN) { EE(acc, cur, wr, wc, fr, fq); S.done(cur); }
        if (!has_next) break;
#pragma unroll
        for (int a = 0; a < 2; ++a)
#pragma unroll
            for (int b = 0; b < 2; ++b)
#pragma unroll
                for (int m = 0; m < 4; ++m)
#pragma unroll
                    for (int n = 0; n < 2; ++n) acc[a][b][m][n] = (f32x4){0.f, 0.f, 0.f, 0.f};
        cur = nxt; cA = nA; cB = nB; ++ui;
        if constexpr (ALIGN_EPI) { if (wr == 1) PG8_BAR; }
    }
    PG8_WAIT_V(0);
    if constexpr (!ALIGN_EPI) { if (wr == 0) PG8_BAR; }
    PG8_BAR;
    if constexpr (Epi::AFTER_DRAIN) { E.fused(acc, cur, wr, wc, fr, fq, lds, wid, lane); S.done(cur); }
#undef PG8_SA
#undef PG8_SB
#undef PG8_STAGE
#undef PG8_LDA
#undef PG8_LDB
#undef PG8_MMA
#undef PG8_WAIT_V
#undef PG8_WAIT_L
#undef PG8_BAR
#undef PG8_SCHED
}
}

#define LAS __attribute__((address_space(3)))
typedef unsigned short bf16;
typedef float f32x4 __attribute__((ext_vector_type(4)));
typedef unsigned v4u __attribute__((ext_vector_type(4)));
typedef unsigned v2u __attribute__((ext_vector_type(2)));
constexpr int NB = 4, SEQ = 8192, D = 1024, T = NB * SEQ, DEPTH = 2;
constexpr int P_IN = 2320, N_IN = 2560, ZLD = 2304, FF = 2816, FF2 = 5632;
constexpr int ZQ = 0, ZK = 256, ZV = 512, ZR = 1024, ZSQ = 1536, ZSK = 2048, ZSV = 2176;
constexpr int NCHUNK = SEQ / 64, NUNIT = NB * 4 * NCHUNK;
constexpr float EPS = 1e-6f;
constexpr size_t MiB = 1u << 20;
constexpr size_t WS_WIN = 0, WS_WOUT = 10 * MiB, WS_WUP = 14 * MiB, WS_WDN = 36 * MiB, WS_SSQ = 47 * MiB, WS_HP = 49 * MiB, WS_HC = 55 * MiB, WS_DEC = 61 * MiB,
                 WS_XB = 62 * MiB, WS_OMIX = 126 * MiB, WS_Z = 190 * MiB, WS_LA = 334 * MiB, WS_ACT = 190 * MiB, WS_ST = 366 * MiB, WS_SP = 430 * MiB, WS_CTL = 462 * MiB, WS_END = 463 * MiB;
constexpr size_t CTL_ZERO_BYTES = 16384;
constexpr int LDS_BYTES = 157696, XOFF = 131072, RALL_OFF = 145408;

#define LDS_WAIT() asm volatile("s_waitcnt lgkmcnt(0)" ::: "memory")
#define LDSBAR() do { asm volatile("s_waitcnt lgkmcnt(0)" ::: "memory"); __builtin_amdgcn_s_barrier(); asm volatile("" ::: "memory"); } while (0)
__device__ __forceinline__ unsigned f2bf(float f) { unsigned u = __builtin_bit_cast(unsigned, f); return (u + 0x7fffu + ((u >> 16) & 1u)) >> 16; }
__device__ __forceinline__ unsigned pk2(float lo, float hi) { return f2bf(lo) | (f2bf(hi) << 16); }
__device__ __forceinline__ float bf2f(unsigned short h) { return __builtin_bit_cast(float, (unsigned)h << 16); }
__device__ __forceinline__ float bflo(unsigned w) { return __builtin_bit_cast(float, w << 16); }
__device__ __forceinline__ float bfhi(unsigned w) { return __builtin_bit_cast(float, w & 0xffff0000u); }
__device__ __forceinline__ float wave_sum(float v) {
#pragma unroll
    for (int o = 1; o < 64; o <<= 1) v += __shfl_xor(v, o);
    return v;
}
__device__ __forceinline__ float silu_f(float x) { return x * __builtin_amdgcn_rcpf(1.0f + __expf(-x)); }


typedef short bf16x8 __attribute__((ext_vector_type(8)));
__device__ __forceinline__ bf16x8 mk8(unsigned a, unsigned b, unsigned c, unsigned d) { v4u w; w.x = a; w.y = b; w.z = c; w.w = d; return __builtin_bit_cast(bf16x8, w); }
__device__ __forceinline__ f32x4 mfma16(bf16x8 x, bf16x8 y, f32x4 c) { return __builtin_amdgcn_mfma_f32_16x16x32_bf16(x, y, c, 0, 0, 0); }
typedef float f32x2_t __attribute__((ext_vector_type(2)));
typedef __bf16 bf16x2_t __attribute__((ext_vector_type(2)));
__device__ __forceinline__ unsigned cvtpk(float lo, float hi) { f32x2_t v = {lo, hi}; bf16x2_t b = __builtin_convertvector(v, bf16x2_t); return __builtin_bit_cast(unsigned, b); }

struct Args { const float* in[15]; float* out; unsigned char* ws; };

typedef const __attribute__((address_space(4))) char* kptr_t;
__device__ __forceinline__ kptr_t kargp() { kptr_t kp = (kptr_t)__builtin_amdgcn_kernarg_segment_ptr(); asm volatile("" : "+s"(kp)); return kp; }
__device__ __forceinline__ const float* arg_in(int i) { return *(const float* const __attribute__((address_space(4)))*)(kargp() + 8 * i); }
__device__ __forceinline__ float* arg_out() { return *(float* const __attribute__((address_space(4)))*)(kargp() + 8 * 15); }
__device__ __forceinline__ unsigned char* arg_ws() { return *(unsigned char* const __attribute__((address_space(4)))*)(kargp() + 8 * 16); }
__device__ __forceinline__ unsigned char* wsp(const Args& a) { unsigned char* p = a.ws; asm volatile("" : "+s"(p)); return p; }

template <class Src> __device__ __forceinline__ void tr_item(Src src, int K, bf16* WT, int nblk, LAS float* scr, int item, int lane) {
    const int kb = item / nblk, nb = item % nblk, k0 = 64 * kb, n0 = 32 * nb;
#pragma unroll 8
    for (int i = 0; i < 32; ++i) { const int kk = 2 * i + (lane >> 5); scr[kk * 33 + (lane & 31)] = src(k0 + kk, n0 + (lane & 31)); }
    LDS_WAIT(); asm volatile("" ::: "memory");
    const int c = lane & 7;
#pragma unroll
    for (int j = 0; j < 4; ++j) { const int n = (lane >> 3) + 8 * j; const LAS float* s = scr + (8 * c) * 33 + n;
        v4u o; o.x = pk2(s[0 * 33], s[1 * 33]); o.y = pk2(s[2 * 33], s[3 * 33]); o.z = pk2(s[4 * 33], s[5 * 33]); o.w = pk2(s[6 * 33], s[7 * 33]);
        *(v4u*)(WT + (size_t)(n0 + n) * K + k0 + 8 * c) = o; }
    LDS_WAIT(); asm volatile("" ::: "memory");
}

__device__ __forceinline__ void tr_item16(const float* Wsrc, int ldw, const float* g, int K, bf16* WT, int k0, int n0, LAS float* scr, int lane) {
    const int r8 = lane >> 3, c4 = lane & 7;
#pragma unroll
    for (int i = 0; i < 8; ++i) { const int kk = 8 * i + r8; const f32x4 v = *(const f32x4*)(Wsrc + (size_t)(k0 + kk) * ldw + 4 * c4); const float gk = g ? g[k0 + kk] : 1.0f;
        LAS float* s = scr + kk * 33 + 4 * c4; s[0] = v[0] * gk; s[1] = v[1] * gk; s[2] = v[2] * gk; s[3] = v[3] * gk; }
    LDS_WAIT(); asm volatile("" ::: "memory");
    const int c = lane & 7;
#pragma unroll
    for (int j = 0; j < 4; ++j) { const int n = (lane >> 3) + 8 * j; const LAS float* s = scr + (8 * c) * 33 + n;
        v4u o; o.x = pk2(s[0 * 33], s[1 * 33]); o.y = pk2(s[2 * 33], s[3 * 33]); o.z = pk2(s[4 * 33], s[5 * 33]); o.w = pk2(s[6 * 33], s[7 * 33]);
        *(v4u*)(WT + (size_t)(n0 + n) * K + k0 + 8 * c) = o; }
    LDS_WAIT(); asm volatile("" ::: "memory");
}

__device__ __forceinline__ void p0_prologue(const Args& a, LAS unsigned char* lds, int G) {
    unsigned char* const wsx = arg_ws();
    int tid_ = threadIdx.x; asm volatile("" : "+v"(tid_)); const int tid = tid_, lane = tid & 63, wave = tid >> 6;
    LAS float* scr = (LAS float*)(lds + wave * 16384);
    const int gw = blockIdx.x * 8 + wave, NGW = G * 8;
    constexpr int I_IN = 16 * (N_IN / 32), I_OUT = 16 * (D / 32), I_UP = 16 * (FF2 / 32), I_DN = (FF / 64) * (D / 32), I_L = I_IN + I_OUT + I_UP + I_DN;
    for (int it = gw; it < DEPTH * I_L; it += NGW) {
        const int l = it / I_L; int r = it % I_L;
        if (r < I_IN) {
            const float* W = arg_in(2) + (size_t)l * D * P_IN; const float* g = arg_in(1) + l * D; const float* wa2 = arg_in(3) + l * 16 * 256;
            bf16* WT = (bf16*)(wsx + WS_WIN) + (size_t)l * N_IN * D;
            { const int nblk_ = N_IN / 32, kb_ = r / nblk_, nb_ = r % nblk_, n0_ = 32 * nb_;
              if (n0_ < 2304) { tr_item16(W + (n0_ < 1536 ? n0_ : n0_ + 16), P_IN, g, D, WT, 64 * kb_, n0_, scr, lane); continue; } }
            tr_item([=](int k, int n) -> float {
                const float gk = g[k];
                if (n < 2304) return W[(size_t)k * P_IN + (n < 1536 ? n : n + 16)] * gk;
                float s = 0.f; const float* wr = W + (size_t)k * P_IN + 1536; const int c = n - 2304;
#pragma unroll
                for (int q = 0; q < 16; ++q) s += wr[q] * wa2[q * 256 + c];
                return s * gk; }, D, WT, N_IN / 32, scr, r, lane);
            continue; }
        r -= I_IN;
        if (r < I_OUT) { const float* W = arg_in(9) + (size_t)l * D * D; bf16* WT = (bf16*)(wsx + WS_WOUT) + (size_t)l * D * D;
            { const int nblk_ = D / 32, kb_ = r / nblk_, nb_ = r % nblk_; tr_item16(W + 32 * nb_, D, nullptr, D, WT, 64 * kb_, 32 * nb_, scr, lane); } continue; }
        r -= I_OUT;
        if (r < I_UP) { const float* W = arg_in(11) + (size_t)l * D * FF2; const float* g = arg_in(10) + l * D; bf16* WT = (bf16*)(wsx + WS_WUP) + (size_t)l * FF2 * D;
            { const int nblk_ = FF2 / 32, kb_ = r / nblk_, nb_ = r % nblk_, n0_ = 32 * nb_, pn_ = n0_ >> 8, bj_ = (n0_ >> 7) & 1, j_ = n0_ & 127;
              tr_item16(W + bj_ * FF + 128 * pn_ + j_, FF2, g, D, WT, 64 * kb_, n0_, scr, lane); } continue; }
        r -= I_UP;
        { const float* W = arg_in(14) + (size_t)l * FF * D; bf16* WT = (bf16*)(wsx + WS_WDN) + (size_t)l * D * FF;
            { const int nblk_ = D / 32, kb_ = r / nblk_, nb_ = r % nblk_; tr_item16(W + 32 * nb_, D, nullptr, FF, WT, 64 * kb_, 32 * nb_, scr, lane); } }
    }
    const float* x = arg_in(0); bf16* XB = (bf16*)(wsx + WS_XB); float* SSQ = (float*)(wsx + WS_SSQ);
    for (int m = gw; m < T; m += NGW) {
        const f32x4* xr = (const f32x4*)(x + (size_t)m * D) + lane; f32x4 v[4]; float s = 0.f;
#pragma unroll
        for (int j = 0; j < 4; ++j) { v[j] = xr[64 * j]; s += (v[j][0] * v[j][0] + v[j][1] * v[j][1]) + (v[j][2] * v[j][2] + v[j][3] * v[j][3]); }
        s = wave_sum(s);
        v2u* o8 = (v2u*)(XB + (size_t)m * D) + lane;
#pragma unroll
        for (int j = 0; j < 4; ++j) { v2u w; w.x = pk2(v[j][0], v[j][1]); w.y = pk2(v[j][2], v[j][3]); o8[64 * j] = w; }
        if (lane < 16) SSQ[(size_t)m * 16 + lane] = (lane == 0) ? s : 0.f;
    }
}

__device__ __forceinline__ void gla_a_phase(const Args& a, LAS unsigned char* lds, int G) {
    unsigned char* const wsx = arg_ws();
    int tid_ = threadIdx.x; asm volatile("" : "+v"(tid_)); const int tid = tid_, hw = tid >> 8, t = tid & 255, d = t & 63, seg = t >> 6, segs = __builtin_amdgcn_readfirstlane(seg);
    LAS unsigned char* base = lds + hw * 40960;
    LAS float* tot = (LAS float*)base; LAS bf16* kdT = (LAS bf16*)(base + 1024); LAS bf16* vT = (LAS bf16*)(base + 10240);
    const bf16* Z = (const bf16*)(wsx + WS_Z); const float* LA = (const float*)(wsx + WS_LA); bf16* ST = (bf16*)(wsx + WS_ST); float* DEC = (float*)(wsx + WS_DEC);
    const int dp = t & 31, rg = t >> 5, d0 = 2 * dp;
    LAS float* tot2 = (LAS float*)(base + 28672);
    f32x2_t lav[8]; unsigned kraw[8]; v4u vw[4];
#define GA_LOAD(pp) do { const int unit_ = 2 * (pp) + hw, n_ = unit_ & (NCHUNK - 1), bh_ = unit_ >> 7, h_ = bh_ & 3, b_ = bh_ >> 2, tok_ = b_ * SEQ + n_ * 64; \
        _Pragma("unroll") for (int i = 0; i < 8; ++i) { const size_t row_ = (size_t)(tok_ + 8 * rg + i); { const unsigned lw_ = *(const unsigned*)((const bf16*)LA + row_ * 256 + h_ * 64 + d0); lav[i] = (f32x2_t){bflo(lw_), bfhi(lw_)}; } kraw[i] = *(const unsigned*)(Z + row_ * ZLD + ZK + h_ * 64 + d0); } \
        _Pragma("unroll") for (int it = 0; it < 4; ++it) { const int id = t + 256 * (it >> 1), row = 2 * (id >> 4) + (it & 1), cg8 = id & 15; vw[it] = *(const v4u*)(Z + (size_t)(tok_ + row) * ZLD + ZV + h_ * 128 + 8 * cg8); } } while (0)
    if ((int)blockIdx.x < NUNIT / 2) GA_LOAD((int)blockIdx.x);
    for (int p = blockIdx.x; p < NUNIT / 2; p += G) {
        const int unit = 2 * p + hw, n = unit & (NCHUNK - 1), bh = unit >> 7, h = bh & 3, b = bh >> 2;
        const int tok0 = b * SEQ + n * 64;
        float b0[8], b1[8]; float r0 = 0.f, r1 = 0.f;
#pragma unroll
        for (int i = 0; i < 8; ++i) { r0 += lav[i].x; b0[i] = r0; r1 += lav[i].y; b1[i] = r1; }
        *(LAS f32x2_t*)(tot2 + rg * 64 + d0) = (f32x2_t){r0, r1};
        LDSBAR();
        float o0 = 0.f, o1 = 0.f, bl0 = 0.f, bl1 = 0.f;
#pragma unroll
        for (int s = 0; s < 8; ++s) { const f32x2_t tv = *(const LAS f32x2_t*)(tot2 + s * 64 + d0); bl0 += tv.x; bl1 += tv.y; if (s < rg) { o0 += tv.x; o1 += tv.y; } }
        { float k0[8], k1[8];
#pragma unroll
          for (int i = 0; i < 8; ++i) { k0[i] = bflo(kraw[i]) * __expf(bl0 - (b0[i] + o0)); k1[i] = bfhi(kraw[i]) * __expf(bl1 - (b1[i] + o1)); }
          v4u w0, w1; w0.x = cvtpk(k0[0], k0[1]); w0.y = cvtpk(k0[2], k0[3]); w0.z = cvtpk(k0[4], k0[5]); w0.w = cvtpk(k0[6], k0[7]); w1.x = cvtpk(k1[0], k1[1]); w1.y = cvtpk(k1[2], k1[3]); w1.z = cvtpk(k1[4], k1[5]); w1.w = cvtpk(k1[6], k1[7]);
          *(LAS v4u*)(kdT + d0 * 72 + 8 * rg) = w0; *(LAS v4u*)(kdT + (d0 + 1) * 72 + 8 * rg) = w1; }
        if (rg == 0) *(f32x2_t*)(DEC + (size_t)unit * 64 + d0) = (f32x2_t){__expf(bl0), __expf(bl1)};
#pragma unroll
        for (int it = 0; it < 2; ++it) { const int id = t + 256 * it, rp = id >> 4, cg8 = id & 15;
            const v4u w0 = vw[2 * it], w1 = vw[2 * it + 1];
            LAS unsigned* vp = (LAS unsigned*)(vT + (8 * cg8) * 72 + 2 * rp);
            vp[0 * 36] = (w0.x & 0xffff) | (w1.x << 16); vp[1 * 36] = (w0.x >> 16) | (w1.x & 0xffff0000u); vp[2 * 36] = (w0.y & 0xffff) | (w1.y << 16); vp[3 * 36] = (w0.y >> 16) | (w1.y & 0xffff0000u);
            vp[4 * 36] = (w0.z & 0xffff) | (w1.z << 16); vp[5 * 36] = (w0.z >> 16) | (w1.z & 0xffff0000u); vp[6 * 36] = (w0.w & 0xffff) | (w1.w << 16); vp[7 * 36] = (w0.w >> 16) | (w1.w & 0xffff0000u); }
        LDSBAR();
        if (p + G < NUNIT / 2) GA_LOAD(p + G);
        {
            const int fr = t & 15, fq = (t >> 4) & 3;
            bf16x8 Xk[2];
#pragma unroll
            for (int ks = 0; ks < 2; ++ks) Xk[ks] = *(const LAS bf16x8*)(kdT + (16 * seg + fr) * 72 + 32 * ks + 8 * fq);
#pragma unroll
            for (int vb = 0; vb < 8; ++vb) { f32x4 acc = (f32x4){0.f, 0.f, 0.f, 0.f};
#pragma unroll
                for (int ks = 0; ks < 2; ++ks) acc = mfma16(Xk[ks], *(const LAS bf16x8*)(vT + (16 * vb + fr) * 72 + 32 * ks + 8 * fq), acc);
                v2u sw; sw.x = cvtpk(acc[0], acc[1]); sw.y = cvtpk(acc[2], acc[3]); *(v2u*)(ST + (size_t)unit * 8192 + (16 * vb + fr) * 64 + 16 * seg + 4 * fq) = sw; }
        }
        LDSBAR();
    }
#undef GA_LOAD
}

__device__ __forceinline__ void gla_scan_phase(const Args& a, int G) {
    unsigned char* const wsx = arg_ws();
    const unsigned* ST = (const unsigned*)(wsx + WS_ST); const float* DEC = (const float*)(wsx + WS_DEC); unsigned* SP = (unsigned*)(wsx + WS_SP);
    int tid_ = threadIdx.x; asm volatile("" : "+v"(tid_));
    if (tid_ >= 256) return;
    for (int e = blockIdx.x * 256 + tid_; e < 16 * 4096; e += G * 256) {
        const int bh = e >> 12, ep = e & 4095, d = (2 * ep) & 63; float S0 = 0.f, S1 = 0.f;
        const unsigned* stp = ST + (size_t)bh * NCHUNK * 4096 + ep; const float* dp = DEC + (size_t)bh * NCHUNK * 64 + d; unsigned* sp = SP + (size_t)bh * NCHUNK * 4096 + ep;
#pragma unroll 1
        for (int n0 = 0; n0 < NCHUNK; n0 += 32) {
            unsigned cs[32]; float d0[32], d1[32];
#pragma unroll
            for (int j = 0; j < 32; ++j) { cs[j] = stp[(size_t)(n0 + j) * 4096]; const f32x2_t dd = *(const f32x2_t*)(dp + (n0 + j) * 64); d0[j] = dd.x; d1[j] = dd.y; }
#pragma unroll
            for (int j = 0; j < 32; ++j) { sp[(size_t)(n0 + j) * 4096] = cvtpk(S0, S1); S0 = S0 * d0[j] + bflo(cs[j]); S1 = S1 * d1[j] + bfhi(cs[j]); }
        }
    }
}

__device__ __forceinline__ void gla_c_phase(const Args& a, int l, LAS unsigned char* lds, int G) {
    unsigned char* const wsx = arg_ws();
    int tid_ = threadIdx.x; asm volatile("" : "+v"(tid_)); const int tid = tid_, hw = tid >> 8, t = tid & 255, d = t & 63, seg = t >> 6, segs = __builtin_amdgcn_readfirstlane(seg);
    LAS unsigned char* base = lds + hw * 65536;
    LAS float* tot = (LAS float*)base; LAS bf16* qe = (LAS bf16*)(base + 1024); LAS bf16* ke = (LAS bf16*)(base + 10240); LAS bf16* vT = (LAS bf16*)(base + 19456);
    LAS float* Am = (LAS float*)(base + 37888); LAS float* rsum = (LAS float*)(base + 54528);
    const bf16* Z = (const bf16*)(wsx + WS_Z); const float* LA = (const float*)(wsx + WS_LA); const bf16* SP = (const bf16*)(wsx + WS_SP); bf16* OMIX = (bf16*)(wsx + WS_OMIX);
    const float* gnorm = arg_in(5) + l * 128;
    LAS float* gnl = (LAS float*)(lds + 131072);
    if (tid < 128) gnl[tid] = gnorm[tid];
    LDSBAR();
    const int dp = t & 31, rg = t >> 5, d0 = 2 * dp;
    LAS float* tot2 = (LAS float*)(base + 37888);
    f32x2_t lav[8]; unsigned qraw[8], kraw[8]; v4u vw[4];
#define GC_LOAD(pp) do { const int unit_ = 2 * (pp) + hw, n_ = unit_ & (NCHUNK - 1), bh_ = unit_ >> 7, h_ = bh_ & 3, b_ = bh_ >> 2, tok_ = b_ * SEQ + n_ * 64; \
        _Pragma("unroll") for (int i = 0; i < 8; ++i) { const size_t row_ = (size_t)(tok_ + 8 * rg + i); { const unsigned lw_ = *(const unsigned*)((const bf16*)LA + row_ * 256 + h_ * 64 + d0); lav[i] = (f32x2_t){bflo(lw_), bfhi(lw_)}; } qraw[i] = *(const unsigned*)(Z + row_ * ZLD + ZQ + h_ * 64 + d0); kraw[i] = *(const unsigned*)(Z + row_ * ZLD + ZK + h_ * 64 + d0); } \
        _Pragma("unroll") for (int it = 0; it < 4; ++it) { const int id = t + 256 * (it >> 1), row = 2 * (id >> 4) + (it & 1), cg8 = id & 15; vw[it] = *(const v4u*)(Z + (size_t)(tok_ + row) * ZLD + ZV + h_ * 128 + 8 * cg8); } } while (0)
    if ((int)blockIdx.x < NUNIT / 2) GC_LOAD((int)blockIdx.x);
    for (int p = blockIdx.x; p < NUNIT / 2; p += G) {
        const int unit = 2 * p + hw, n = unit & (NCHUNK - 1), bh = unit >> 7, h = bh & 3, b = bh >> 2;
        const int tok0 = b * SEQ + n * 64;
        bf16x8 Xs[8][2]; v2u grw[8];
        { const int fr = t & 15, fq = (t >> 4) & 3;
#pragma unroll
          for (int vb = 0; vb < 8; ++vb) {
#pragma unroll
              for (int ks = 0; ks < 2; ++ks) Xs[vb][ks] = *(const bf16x8*)(SP + (size_t)unit * 8192 + (32 * (vb >> 1) + 8 * (fr >> 2) + 4 * (vb & 1) + (fr & 3)) * 64 + 32 * ks + 8 * fq);
              grw[vb] = *(const v2u*)(Z + (size_t)(tok0 + 16 * seg + fr) * ZLD + ZR + h * 128 + 32 * (vb >> 1) + 8 * fq + 4 * (vb & 1)); } }
        float b0[8], b1[8]; float r0 = 0.f, r1 = 0.f;
#pragma unroll
        for (int i = 0; i < 8; ++i) { r0 += lav[i].x; b0[i] = r0; r1 += lav[i].y; b1[i] = r1; }
        *(LAS f32x2_t*)(tot2 + rg * 64 + d0) = (f32x2_t){r0, r1};
        LDSBAR();
        float o0 = 0.f, o1 = 0.f;
#pragma unroll
        for (int s = 0; s < 8; ++s) { const f32x2_t tv = *(const LAS f32x2_t*)(tot2 + s * 64 + d0); if (s < rg) { o0 += tv.x; o1 += tv.y; } }
#pragma unroll
        for (int i = 0; i < 8; ++i) { const int c = 8 * rg + i; const float bb0 = b0[i] + o0, bb1 = b1[i] + o1;
            *(LAS unsigned*)(qe + c * 72 + d0) = cvtpk(bflo(qraw[i]) * __expf(bb0), bfhi(qraw[i]) * __expf(bb1));
            *(LAS unsigned*)(ke + c * 72 + d0) = cvtpk(bflo(kraw[i]) * __expf(-bb0), bfhi(kraw[i]) * __expf(-bb1)); }
#pragma unroll
        for (int it = 0; it < 2; ++it) { const int id = t + 256 * it, rp = id >> 4, cg8 = id & 15;
            const v4u w0 = vw[2 * it], w1 = vw[2 * it + 1];
            LAS unsigned* vp = (LAS unsigned*)(vT + (8 * cg8) * 72 + 2 * rp);
            vp[0 * 36] = (w0.x & 0xffff) | (w1.x << 16); vp[1 * 36] = (w0.x >> 16) | (w1.x & 0xffff0000u); vp[2 * 36] = (w0.y & 0xffff) | (w1.y << 16); vp[3 * 36] = (w0.y >> 16) | (w1.y & 0xffff0000u);
            vp[4 * 36] = (w0.z & 0xffff) | (w1.z << 16); vp[5 * 36] = (w0.z >> 16) | (w1.z & 0xffff0000u); vp[6 * 36] = (w0.w & 0xffff) | (w1.w << 16); vp[7 * 36] = (w0.w >> 16) | (w1.w & 0xffff0000u); }
        LDSBAR();
        if (p + G < NUNIT / 2) GC_LOAD(p + G);
        {
            const int fr = t & 15, fq = (t >> 4) & 3;
            bf16x8 Yq[2];
#pragma unroll
            for (int ks = 0; ks < 2; ++ks) Yq[ks] = *(const LAS bf16x8*)(qe + (16 * seg + fr) * 72 + 32 * ks + 8 * fq);
            f32x4 sc[4];
#pragma unroll
            for (int sb = 0; sb < 4; ++sb) { sc[sb] = (f32x4){0.f, 0.f, 0.f, 0.f};
                if (sb <= segs) {
#pragma unroll
                    for (int ks = 0; ks < 2; ++ks) sc[sb] = mfma16(*(const LAS bf16x8*)(ke + (16 * sb + fr) * 72 + 32 * ks + 8 * fq), Yq[ks], sc[sb]);
                    if (sb == segs) {
#pragma unroll
                        for (int e = 0; e < 4; ++e) sc[sb][e] = (4 * fq + e <= fr) ? sc[sb][e] : 0.f; }
                } }
            f32x4 o[8];
#pragma unroll
            for (int vb = 0; vb < 8; ++vb) o[vb] = (f32x4){0.f, 0.f, 0.f, 0.f};
#pragma unroll
            for (int k2 = 0; k2 < 2; ++k2) {
                if (2 * k2 <= segs) {
                    const bf16x8 P = mk8(cvtpk(sc[2 * k2][0], sc[2 * k2][1]), cvtpk(sc[2 * k2][2], sc[2 * k2][3]), cvtpk(sc[2 * k2 + 1][0], sc[2 * k2 + 1][1]), cvtpk(sc[2 * k2 + 1][2], sc[2 * k2 + 1][3]));
#pragma unroll
                    for (int vb = 0; vb < 8; ++vb) { const LAS bf16* vp = vT + (32 * (vb >> 1) + 8 * (fr >> 2) + 4 * (vb & 1) + (fr & 3)) * 72 + 32 * k2 + 4 * fq;
                        const v2u lo = *(const LAS v2u*)vp, hi = *(const LAS v2u*)(vp + 16);
                        o[vb] = mfma16(mk8(lo.x, lo.y, hi.x, hi.y), P, o[vb]); }
                } }
#pragma unroll
            for (int ks = 0; ks < 2; ++ks)
#pragma unroll
                for (int vb = 0; vb < 8; ++vb) o[vb] = mfma16(Xs[vb][ks], Yq[ks], o[vb]);
            float ss = 0.f;
#pragma unroll
            for (int vb = 0; vb < 8; ++vb) ss += (o[vb][0] * o[vb][0] + o[vb][1] * o[vb][1]) + (o[vb][2] * o[vb][2] + o[vb][3] * o[vb][3]);
            ss += __shfl_xor(ss, 16); ss += __shfl_xor(ss, 32);
            const float r = rsqrtf(ss * (1.0f / 128.0f) + EPS);
            const size_t tok = (size_t)(tok0 + 16 * seg + fr);
#pragma unroll
            for (int vp2 = 0; vp2 < 4; ++vp2) { const int vc = 32 * vp2 + 8 * fq;
                const v2u g0 = grw[2 * vp2], g1 = grw[2 * vp2 + 1]; const f32x4 n0 = *(const LAS f32x4*)(gnl + vc), n1 = *(const LAS f32x4*)(gnl + vc + 4);
                const f32x4 oa = o[2 * vp2], ob = o[2 * vp2 + 1];
                v4u w; w.x = cvtpk(oa[0] * r * n0[0] * bflo(g0.x), oa[1] * r * n0[1] * bfhi(g0.x)); w.y = cvtpk(oa[2] * r * n0[2] * bflo(g0.y), oa[3] * r * n0[3] * bfhi(g0.y));
                w.z = cvtpk(ob[0] * r * n1[0] * bflo(g1.x), ob[1] * r * n1[1] * bfhi(g1.x)); w.w = cvtpk(ob[2] * r * n1[2] * bflo(g1.y), ob[3] * r * n1[3] * bfhi(g1.y));
                *(v4u*)(OMIX + tok * D + h * 128 + vc) = w; }
        }
        LDSBAR();
    }
#undef GC_LOAD
}

__device__ __forceinline__ void swa_phase(const Args& a, int l, LAS unsigned char* lds, int G) {
    unsigned char* const wsx = arg_ws();
    int tid_ = threadIdx.x; asm volatile("" : "+v"(tid_)); const int tid = tid_, lane = tid & 63, w = tid >> 6, fr0 = lane & 15, fq0 = lane >> 4;
    LAS bf16* Kn = (LAS bf16*)lds; LAS bf16* vT = (LAS bf16*)(lds + 36864);
    const bf16* Z = (const bf16*)(wsx + WS_Z); bf16* OMIX = (bf16*)(wsx + WS_OMIX);
    const float* qn = arg_in(6) + l * 64; const float* kn = arg_in(7) + l * 64; const float* sinks = arg_in(8) + l * 8;
    constexpr float LOG2E = 1.4426950408889634f;
    v4u kw[4], va[2], vb[2], qnx0, qnx1;
#define SWA_LOAD(uu) do { const int kvh_ = (uu) & 1, nbk_ = ((uu) >> 1) & 63, b_ = (uu) >> 7; \
        { const int j_ = tid >> 1, hf_ = tid & 1; int tok_ = b_ * SEQ + (nbk_ - 1) * 128 + j_; if (tok_ < b_ * SEQ) tok_ = b_ * SEQ; \
          const v4u* kp_ = (const v4u*)(Z + (size_t)tok_ * ZLD + ZSK + kvh_ * 64 + hf_ * 32); \
          const int jp_ = tid >> 2, qd_ = tid & 3; int tv_ = b_ * SEQ + (nbk_ - 1) * 128 + 2 * jp_; if (tv_ < b_ * SEQ) tv_ = b_ * SEQ; \
          const v4u* vp0_ = (const v4u*)(Z + (size_t)tv_ * ZLD + ZSV + kvh_ * 64 + qd_ * 16); const v4u* vp1_ = (const v4u*)(Z + (size_t)(tv_ + 1) * ZLD + ZSV + kvh_ * 64 + qd_ * 16); \
          _Pragma("unroll") for (int c = 0; c < 4; ++c) kw[c] = kp_[c]; \
          va[0] = vp0_[0]; va[1] = vp0_[1]; vb[0] = vp1_[0]; vb[1] = vp1_[1]; } \
        { const size_t tq_ = (size_t)b_ * SEQ + nbk_ * 128 + 16 * w + fr0; qnx0 = *(const v4u*)(Z + tq_ * ZLD + ZSQ + kvh_ * 256 + 8 * fq0); qnx1 = *(const v4u*)(Z + tq_ * ZLD + ZSQ + kvh_ * 256 + 32 + 8 * fq0); } } while (0)
    if ((int)blockIdx.x < NB * 64 * 2) SWA_LOAD((int)blockIdx.x);
    for (int unit = blockIdx.x; unit < NB * 64 * 2; unit += G) {
        const int kvh = unit & 1, nbk = (unit >> 1) & 63, b = unit >> 7;
        v4u qn0 = qnx0, qn1 = qnx1;
#ifdef PROBE_SWA_STAGE
        for (int rep_ = 0; rep_ < 2; ++rep_) { if (rep_) LDSBAR();
#endif
        {
            const int j = tid >> 1, hf = tid & 1, jp = tid >> 2, qd = tid & 3;
            float ss = 0.f;
#pragma unroll
            for (int c = 0; c < 4; ++c) { const float e0 = bflo(kw[c].x), e1 = bfhi(kw[c].x), e2 = bflo(kw[c].y), e3 = bfhi(kw[c].y), e4 = bflo(kw[c].z), e5 = bfhi(kw[c].z), e6 = bflo(kw[c].w), e7 = bfhi(kw[c].w);
                ss += ((e0 * e0 + e1 * e1) + (e2 * e2 + e3 * e3)) + ((e4 * e4 + e5 * e5) + (e6 * e6 + e7 * e7)); }
            ss += __shfl_xor(ss, 1);
            const float r = rsqrtf(ss * (1.0f / 64.0f) + EPS);
#pragma unroll
            for (int c = 0; c < 4; ++c) { const f32x4 g0 = *(const f32x4*)(kn + hf * 32 + 8 * c), g1 = *(const f32x4*)(kn + hf * 32 + 8 * c + 4);
                v4u o; o.x = cvtpk(bflo(kw[c].x) * r * g0[0], bfhi(kw[c].x) * r * g0[1]); o.y = cvtpk(bflo(kw[c].y) * r * g0[2], bfhi(kw[c].y) * r * g0[3]);
                o.z = cvtpk(bflo(kw[c].z) * r * g1[0], bfhi(kw[c].z) * r * g1[1]); o.w = cvtpk(bflo(kw[c].w) * r * g1[2], bfhi(kw[c].w) * r * g1[3]);
                *(LAS v4u*)(Kn + j * 72 + hf * 32 + 8 * c) = o; }
#pragma unroll
            for (int c = 0; c < 2; ++c) { LAS unsigned* vs = (LAS unsigned*)(vT + (qd * 16 + 8 * c) * 264 + 2 * jp); const v4u w0 = va[c], w1 = vb[c];
                vs[0 * 132] = (w0.x & 0xffff) | (w1.x << 16); vs[1 * 132] = (w0.x >> 16) | (w1.x & 0xffff0000u); vs[2 * 132] = (w0.y & 0xffff) | (w1.y << 16); vs[3 * 132] = (w0.y >> 16) | (w1.y & 0xffff0000u);
                vs[4 * 132] = (w0.z & 0xffff) | (w1.z << 16); vs[5 * 132] = (w0.z >> 16) | (w1.z & 0xffff0000u); vs[6 * 132] = (w0.w & 0xffff) | (w1.w << 16); vs[7 * 132] = (w0.w >> 16) | (w1.w & 0xffff0000u); }
        }
#ifdef PROBE_SWA_STAGE
        }
#endif
        LDSBAR();
        if (unit + G < NB * 64 * 2) SWA_LOAD(unit + G);
        const f32x4 qg00 = *(const f32x4*)(qn + 8 * fq0), qg01 = *(const f32x4*)(qn + 8 * fq0 + 4), qg10 = *(const f32x4*)(qn + 32 + 8 * fq0), qg11 = *(const f32x4*)(qn + 32 + 8 * fq0 + 4);
        const f32x4 snk4 = *(const f32x4*)(sinks + kvh * 4);
#ifdef PROBE_SWA_HEADS
#pragma unroll 1
        for (int g8 = 0; g8 < 8; ++g8) { const int g = g8 & 3; if (g8 == 4) { const size_t tq = (size_t)b * SEQ + nbk * 128 + 16 * w + fr0; qn0 = *(const v4u*)(Z + tq * ZLD + ZSQ + kvh * 256 + 8 * fq0); qn1 = *(const v4u*)(Z + tq * ZLD + ZSQ + kvh * 256 + 32 + 8 * fq0); }
#else
#pragma unroll 2
        for (int g = 0; g < 4; ++g) {
#endif
            int fr = fr0, fq = fq0; asm volatile("" : "+v"(fr), "+v"(fq));
            const int qh = kvh * 4 + g; const size_t tok = (size_t)b * SEQ + nbk * 128 + 16 * w + fr;
            bf16x8 Yq[2];
            {   const v4u q0 = qn0, q1 = qn1;
                if (g < 3) { qn0 = *(const v4u*)(Z + tok * ZLD + ZSQ + (qh + 1) * 64 + 8 * fq); qn1 = *(const v4u*)(Z + tok * ZLD + ZSQ + (qh + 1) * 64 + 32 + 8 * fq); }
                float qf[16] = {bflo(q0.x), bfhi(q0.x), bflo(q0.y), bfhi(q0.y), bflo(q0.z), bfhi(q0.z), bflo(q0.w), bfhi(q0.w), bflo(q1.x), bfhi(q1.x), bflo(q1.y), bfhi(q1.y), bflo(q1.z), bfhi(q1.z), bflo(q1.w), bfhi(q1.w)};
                float ss = 0.f;
#pragma unroll
                for (int c = 0; c < 16; ++c) ss += qf[c] * qf[c];
                ss += __shfl_xor(ss, 16); ss += __shfl_xor(ss, 32);
                const float r = rsqrtf(ss * (1.0f / 64.0f) + EPS) * (0.125f * LOG2E);
#pragma unroll
                for (int ks = 0; ks < 2; ++ks) { const f32x4 g0 = ks ? qg10 : qg00, g1 = ks ? qg11 : qg01; const float* qq = qf + 8 * ks;
                    Yq[ks] = mk8(cvtpk(qq[0] * r * g0[0], qq[1] * r * g0[1]), cvtpk(qq[2] * r * g0[2], qq[3] * r * g0[3]), cvtpk(qq[4] * r * g1[0], qq[5] * r * g1[1]), cvtpk(qq[6] * r * g1[2], qq[7] * r * g1[3])); }
            }
            f32x4 sc[9];
#pragma unroll
            for (int sb = 0; sb < 9; ++sb) { sc[sb] = (f32x4){0.f, 0.f, 0.f, 0.f};
#pragma unroll
                for (int ks = 0; ks < 2; ++ks) sc[sb] = mfma16(*(const LAS bf16x8*)(Kn + (16 * (w + sb) + fr) * 72 + 32 * ks + 8 * fq), Yq[ks], sc[sb]); }
            const float slope2 = exp2f(-(float)(qh + 1)) * LOG2E, sink2 = (g == 0 ? snk4[0] : g == 1 ? snk4[1] : g == 2 ? snk4[2] : snk4[3]) * LOG2E;
            const float nb = -slope2 * (float)(128 + fr - 4 * fq);
            const int dq = fr - 4 * fq;
            float mx = sink2;
#pragma unroll
            for (int sb = 0; sb < 9; ++sb) { const bool blk = !(nbk == 0 && w + sb < 8);
#pragma unroll
                for (int e = 0; e < 4; ++e) { const bool ok = blk && (sb == 0 ? (e > dq) : (sb == 8 ? (e <= dq) : true));
                    const float v = ok ? sc[sb][e] + (nb + slope2 * (float)(16 * sb + e)) : -INFINITY; sc[sb][e] = v; mx = fmaxf(mx, v); } }
            mx = fmaxf(mx, __shfl_xor(mx, 16)); mx = fmaxf(mx, __shfl_xor(mx, 32));
            float ls = 0.f;
#pragma unroll
            for (int sb = 0; sb < 9; ++sb)
#pragma unroll
                for (int e = 0; e < 4; ++e) { const float p = __builtin_amdgcn_exp2f(sc[sb][e] - mx); sc[sb][e] = p; ls += p; }
            ls += __shfl_xor(ls, 16); ls += __shfl_xor(ls, 32);
            ls += __builtin_amdgcn_exp2f(sink2 - mx);
            f32x4 o[4];
#pragma unroll
            for (int db = 0; db < 4; ++db) o[db] = (f32x4){0.f, 0.f, 0.f, 0.f};
#pragma unroll
            for (int k2 = 0; k2 < 5; ++k2) {
                const bf16x8 P = (k2 < 4) ? mk8(cvtpk(sc[2 * k2][0], sc[2 * k2][1]), cvtpk(sc[2 * k2][2], sc[2 * k2][3]), cvtpk(sc[(2 * k2 + 1) % 9][0], sc[(2 * k2 + 1) % 9][1]), cvtpk(sc[(2 * k2 + 1) % 9][2], sc[(2 * k2 + 1) % 9][3]))
                                          : mk8(cvtpk(sc[8][0], sc[8][1]), cvtpk(sc[8][2], sc[8][3]), 0u, 0u);
#pragma unroll
                for (int db = 0; db < 4; ++db) { const LAS bf16* vp = vT + (32 * (db >> 1) + 8 * (fr >> 2) + 4 * (db & 1) + (fr & 3)) * 264 + 16 * (w + 2 * k2) + 4 * fq;
                    const v2u lo = *(const LAS v2u*)vp, hi = (k2 < 4) ? *(const LAS v2u*)(vp + 16) : lo;
                    o[db] = mfma16(mk8(lo.x, lo.y, hi.x, hi.y), P, o[db]); }
            }
            const float inv = 1.0f / ls;
#pragma unroll
            for (int kk = 0; kk < 2; ++kk) { v4u wv; wv.x = cvtpk(o[2 * kk][0] * inv, o[2 * kk][1] * inv); wv.y = cvtpk(o[2 * kk][2] * inv, o[2 * kk][3] * inv); wv.z = cvtpk(o[2 * kk + 1][0] * inv, o[2 * kk + 1][1] * inv); wv.w = cvtpk(o[2 * kk + 1][2] * inv, o[2 * kk + 1][3] * inv);
                *(v4u*)(OMIX + tok * D + 512 + qh * 64 + 32 * kk + 8 * fq) = wv; }
        }
        LDSBAR();
    }
#undef SWA_LOAD
}

__device__ __forceinline__ void fixup_units(const pg8::StaticOrder& S) {
    unsigned char* const wsx = arg_ws();
    const float* HP = (const float*)(wsx + WS_HP); const float* HC = (const float*)(wsx + WS_HC); bf16* ACT = (bf16*)(wsx + WS_ACT);
    int tid_ = threadIdx.x; asm volatile("" : "+v"(tid_));
    pg8::Unit u;
    for (int i = 0; S.next(i, u); ++i) {
        const int pm = u.pm;
        if ((pm & 31) == 0) continue;
        for (int idx = tid_; idx < 2 * FF; idx += 512) {
            const int j = idx % FF, r = idx / FF;
            const int pn = j >> 7, jj = j & 127, ia = 256 * pn + jj, ib = ia + 128;
            const float* hp = HP + ((size_t)pm * 2 + r) * FF2; const float* hc = HC + ((size_t)(pm - 1) * 2 + (1 - r)) * FF2;
            const float ua = hp[ia] + hc[ia], ub = hp[ib] + hc[ib];
            ACT[(((size_t)pm * (FF / 64) + (j >> 6)) * 256 + r) * 64 + (j & 63)] = (bf16)f2bf(silu_f(ua) * ub);
        }
    }
    asm volatile("s_waitcnt vmcnt(0)" ::: "memory");
    __syncthreads();
}

#define XB_TMO      128
#define XB_XCNT(j)  (256  + 64 * (j))
#define XB_XSUB(j)  (1280 + 64 * (j))
#define XB_XGEN(j)  (2304 + 64 * (j))
#define XB_TOP      3328
#define XB_TOPGEN   3392
#define XCD_BAR_WORDS 3456
#define XB_SPIN_CAP (1u << 18)

__device__ __forceinline__ unsigned xb_ld(unsigned* p)              { return __hip_atomic_load(p, __ATOMIC_RELAXED, __HIP_MEMORY_SCOPE_AGENT); }
__device__ __forceinline__ unsigned xb_add(unsigned* p, unsigned v) { return __hip_atomic_fetch_add(p, v, __ATOMIC_RELAXED, __HIP_MEMORY_SCOPE_AGENT); }
__device__ __forceinline__ unsigned xb_xcc_id() { return (unsigned)__builtin_amdgcn_s_getreg((3 << 11) | 20) & 0xFu; }
#define XB_SPIN(cond, bar) do { unsigned _sp = 0; while (cond) { __builtin_amdgcn_s_sleep(1); \
    if ((++_sp & 255u) == 0u) { if (xb_ld(&(bar)[XB_TMO])) break; if (_sp > XB_SPIN_CAP) { atomicAdd(&(bar)[XB_TMO], 1u); break; } } } } while (0)

struct XcdBarrier {
    unsigned* bar; unsigned x;
    volatile LAS unsigned* st;
};

__device__ __forceinline__ XcdBarrier xcd_barrier_post(unsigned* bar, volatile LAS unsigned* st) {
    XcdBarrier b; b.bar = bar; b.x = xb_xcc_id(); b.st = st;
    if (threadIdx.x == 0) (void)xb_add(&bar[XB_XCNT(b.x)], 1u);
    return b;
}
__device__ __forceinline__ void xcd_barrier_complete(unsigned* bar, unsigned x, unsigned& nloc, unsigned& nx) {
    const unsigned G = gridDim.x * gridDim.y * gridDim.z;
    unsigned sum, cnt, mine, sp = 0u;
    for (;;) {
        sum = 0u; cnt = 0u; mine = 0u;
#pragma unroll
        for (unsigned j = 0; j < 16; ++j) { const unsigned c = xb_ld(&bar[XB_XCNT(j)]); sum += c; cnt += (c > 0u) ? 1u : 0u; mine = (j == x) ? c : mine; }
        if (sum == G) break;
        __builtin_amdgcn_s_sleep(1);
        if ((++sp & 255u) == 0u) { if (xb_ld(&bar[XB_TMO])) break; if (sp > XB_SPIN_CAP) { atomicAdd(&bar[XB_TMO], 1u); break; } }
    }
    nloc = mine > 0u ? mine : 1u; nx = cnt > 0u ? cnt : 1u;
}

__device__ __forceinline__ void xcd_barrier(const XcdBarrier& b) {
    asm volatile("s_waitcnt vmcnt(0)" ::: "memory");
    __syncthreads();
    if (threadIdx.x == 0) {
        unsigned* bar = b.bar;
        __builtin_amdgcn_s_waitcnt(0);
        unsigned nloc = b.st[0], nx = b.st[1];
        const unsigned old = xb_add(&bar[XB_XSUB(b.x)], 1u);
        const unsigned gen = old / nloc;
        if (old + 1u == (gen + 1u) * nloc) {
            __builtin_amdgcn_fence(__ATOMIC_RELEASE, "agent");
            asm volatile("s_waitcnt vmcnt(0)" ::: "memory");
            const unsigned og = xb_add(&bar[XB_TOP], 1u);
            const unsigned tg = og / nx;
            if (og + 1u == (tg + 1u) * nx) xb_add(&bar[XB_TOPGEN], 1u);
            else XB_SPIN(xb_ld(&bar[XB_TOPGEN]) == tg, bar);
            __builtin_amdgcn_fence(__ATOMIC_ACQUIRE, "agent");
            xb_add(&bar[XB_XGEN(b.x)], 1u);
            asm volatile("s_waitcnt vmcnt(0)" ::: "memory");
        } else {
            XB_SPIN(xb_ld(&bar[XB_XGEN(b.x)]) == gen, bar);
            __builtin_amdgcn_fence(__ATOMIC_ACQUIRE, "agent");
            asm volatile("s_waitcnt vmcnt(0)" ::: "memory");
        }
    }
    __syncthreads();
}

__device__ __forceinline__ void rstd_prefill(const pg8::StaticOrder& S, const float* ssq, LAS float* Rall) {
    int tid = threadIdx.x; asm volatile("" : "+v"(tid));
    pg8::Unit u;
    if (tid < 256) for (int i = 0; S.next(i, u); ++i) Rall[i * 256 + tid] = pg8::row_rstd16(ssq, u.pm * 256 + tid);
    __syncthreads();
}
#ifndef REP_G1
#define REP_G1 1
#endif
#ifndef REP_G6
#define REP_G6 1
#endif
#ifndef REP_P0
#define REP_P0 1
#endif
#ifndef REP_GA
#define REP_GA 1
#endif
#ifndef REP_SWA
#define REP_SWA 1
#endif
#ifndef REP_GB
#define REP_GB 1
#endif
#ifndef REP_GC
#define REP_GC 1
#endif
#ifndef REP_FIX
#define REP_FIX 1
#endif
__global__ void __launch_bounds__(512, 2) hymba_fwd(Args a) {
    extern __shared__ __attribute__((aligned(16))) unsigned char lds_raw[];
    LAS unsigned char* lds = (LAS unsigned char*)lds_raw;
    cg::grid_group grid = cg::this_grid();
    const int G = gridDim.x;
    unsigned char* ws = arg_ws();
    volatile LAS unsigned* bst = (volatile LAS unsigned*)(lds + XOFF + 8192 + 1024);
    if (threadIdx.x < 2) bst[threadIdx.x] = 0u;
    __syncthreads();
    const XcdBarrier bar = xcd_barrier_post((unsigned*)(ws + WS_CTL), bst);
#define GSYNC() do { XcdBarrier b2_ = bar; asm volatile("" : "+s"(b2_.x)); xcd_barrier(b2_); } while (0)
#ifndef SK_P0
    for (int rep = 0; rep < REP_P0; ++rep) p0_prologue(a, lds, G);
#endif
    if (threadIdx.x == 0) { unsigned nloc, nx; xcd_barrier_complete(bar.bar, bar.x, nloc, nx); bst[0] = nloc; bst[1] = nx; }
    __syncthreads();
    if (G == 0x7fffffff) grid.sync();
    GSYNC();
    for (int l = 0; l < DEPTH; ++l) {
#ifndef SK_G1
        {
            unsigned char* const ws = arg_ws();
            pg8::Gemm g{(const pg8::bf16_t*)(ws + WS_XB), (const pg8::bf16_t*)(ws + WS_WIN) + (size_t)l * N_IN * D, T, N_IN, D};
            pg8::StaticOrder S; S.init(T, N_IN, G, (int)blockIdx.x);
            rstd_prefill(S, (const float*)(ws + WS_SSQ), (LAS float*)(lds + RALL_OFF));
            pg8::EpiIn E{(pg8::bf16_t*)(ws + WS_Z), (float*)(ws + WS_LA), (const float*)(ws + WS_SSQ), arg_in(4) + l * 256, (LAS float*)(lds + RALL_OFF), 0};
#ifdef PROBE_G1_NOSTORE
            { pg8::EpiIn E2 = E; E2.nostore = (G > 0); pg8::gemm_phase<pg8::EpiIn, pg8::StaticOrder, true, true, D>(lds, g, S, E2); }
#endif
            for (int rep = 0; rep < REP_G1; ++rep) pg8::gemm_phase<pg8::EpiIn, pg8::StaticOrder, true, true, D>(lds, g, S, E);
        }
#endif
        GSYNC();
#ifndef SK_GA
        for (int rep = 0; rep < REP_GA; ++rep) gla_a_phase(a, lds, G);
#endif
#ifndef SK_SWA
        for (int rep = 0; rep < REP_SWA; ++rep) swa_phase(a, l, lds, G);
#endif
        GSYNC();
#ifndef SK_GB
        for (int rep = 0; rep < REP_GB; ++rep) gla_scan_phase(a, G);
#endif
        GSYNC();
#ifndef SK_GC
        for (int rep = 0; rep < REP_GC; ++rep) gla_c_phase(a, l, lds, G);
#endif
        GSYNC();
#ifndef SK_G5
        {
            unsigned char* const ws = arg_ws();
            pg8::Gemm g{(const pg8::bf16_t*)(ws + WS_OMIX), (const pg8::bf16_t*)(ws + WS_WOUT) + (size_t)l * D * D, T, D, D};
            pg8::StaticOrder S; S.init(T, D, G, (int)blockIdx.x);
#ifdef REP_G5X
            { pg8::EpiRes<true> EX{(pg8::bf16_t*)(ws + WS_XB), arg_out(), nullptr}; pg8::gemm_phase<pg8::EpiRes<true>, pg8::StaticOrder, true, true, D>(lds, g, S, EX); }
#endif
            pg8::EpiRes<false> E{(pg8::bf16_t*)(ws + WS_XB), nullptr, (float*)(ws + WS_SSQ)};
            pg8::gemm_phase<pg8::EpiRes<false>, pg8::StaticOrder, true, true, D>(lds, g, S, E);
        }
#endif
        GSYNC();
#ifndef SK_G6
        {
            unsigned char* const ws = arg_ws();
            pg8::Gemm g{(const pg8::bf16_t*)(ws + WS_XB), (const pg8::bf16_t*)(ws + WS_WUP) + (size_t)l * FF2 * D, T, FF2, D};
            pg8::StaticOrder S; S.init(T, FF2, G, (int)blockIdx.x);
            rstd_prefill(S, (const float*)(ws + WS_SSQ), (LAS float*)(lds + RALL_OFF));
            pg8::EpiUp E{(pg8::bf16_t*)(ws + WS_ACT), arg_in(12) + (size_t)l * 3 * FF2, arg_in(13) + (size_t)l * FF2, (float*)(ws + WS_HP), (float*)(ws + WS_HC), (LAS float*)(lds + XOFF), (LAS float*)(lds + RALL_OFF), (LAS float*)(lds + XOFF + 8192 + 2048), {0.f, 0.f}};
            for (int rep = 0; rep < REP_G6; ++rep) pg8::gemm_phase<pg8::EpiUp, pg8::StaticOrder, true, true, D>(lds, g, S, E);
        }
#endif
        GSYNC();
#ifndef SK_G7
        {
            unsigned char* const ws = arg_ws();
            pg8::Gemm g{(const pg8::bf16_t*)(ws + WS_ACT), (const pg8::bf16_t*)(ws + WS_WDN) + (size_t)l * D * FF, T, D, FF};
            pg8::StaticOrder S; S.init(T, D, G, (int)blockIdx.x);
            fixup_units(S);
#ifdef REP_G7X
            { pg8::EpiRes<true> EX{(pg8::bf16_t*)(ws + WS_XB), arg_out(), nullptr}; pg8::gemm_phase<pg8::EpiRes<true>, pg8::StaticOrder, true, true, FF, true>(lds, g, S, EX); }
#endif
            if (l + 1 < DEPTH) { pg8::EpiRes<false> E{(pg8::bf16_t*)(ws + WS_XB), nullptr, (float*)(ws + WS_SSQ)};
                pg8::gemm_phase<pg8::EpiRes<false>, pg8::StaticOrder, true, true, FF, true>(lds, g, S, E); }
            else { pg8::EpiRes<true> E{(pg8::bf16_t*)(ws + WS_XB), arg_out(), nullptr};
                pg8::gemm_phase<pg8::EpiRes<true>, pg8::StaticOrder, true, true, FF, true>(lds, g, S, E); }
        }
#endif
#ifdef PROBE_SYNC
        GSYNC(); GSYNC(); GSYNC(); GSYNC();
#endif
        if (l + 1 < DEPTH) GSYNC();
    }
}

extern "C" void kernel_launch(void* const* d_in, const int* in_sizes, int n_in, void* d_out, int out_size, void* d_ws, size_t ws_size, hipStream_t stream) {
    static int grid = 0;
    if (grid == 0) {
        if (n_in != 15 || out_size != T * D || ws_size < WS_END) { fprintf(stderr, "kernel_launch: unexpected shapes (n_in %d out %d ws %zu)\n", n_in, out_size, ws_size); grid = -1; return; }
        int dev = 0, cus = 0, per_cu = 0;
        hipGetDevice(&dev); hipDeviceGetAttribute(&cus, hipDeviceAttributeMultiprocessorCount, dev);
        hipFuncSetAttribute((const void*)hymba_fwd, hipFuncAttributeMaxDynamicSharedMemorySize, LDS_BYTES);
        hipOccupancyMaxActiveBlocksPerMultiprocessor(&per_cu, (const void*)hymba_fwd, 512, LDS_BYTES);
        if (per_cu < 1) per_cu = 1;
        grid = cus * per_cu;
        (void)hipGetLastError();
    }
    if (grid < 0) return;
    if (hipMemsetAsync((char*)d_ws + WS_CTL, 0, CTL_ZERO_BYTES, stream) != hipSuccess) { fprintf(stderr, "memset failed\n"); return; }
    Args a{};
    for (int i = 0; i < 15; ++i) a.in[i] = (const float*)d_in[i];
    a.out = (float*)d_out; a.ws = (unsigned char*)d_ws;
    void* args[] = {&a};
    hipError_t e = hipLaunchCooperativeKernel((const void*)hymba_fwd, dim3(grid), dim3(512), args, LDS_BYTES, stream);
    if (e != hipSuccess) fprintf(stderr, "cooperative launch failed: %s (grid %d)\n", hipGetErrorString(e), grid);
}
```
